# Optimizing an MI355X kernel written in HIP

```python
import math
import jax, jax.numpy as jnp
from jax import lax
import numpy as np

D_MODEL = 2048
BATCH = 4
SEQ = 8192
DEPTH = 1
DEC_BATCH = 32
DEC_SEQ = 64
PAST_LEN = 4096

CHUNK = 64
QBLOCK = 128
DA_HEADS = 8
DA_HD = 64
DA_WIDTH = DA_HEADS * 2 * DA_HD
RW_HEADS = 16
RW_HD = 64
RW_WIDTH = RW_HEADS * RW_HD
RW_DECAY_LORA = 96
RW_AAA_LORA = 96
RW_GATE_LORA = 256
RW_PROJ = 3 * RW_WIDTH + RW_DECAY_LORA + RW_AAA_LORA + RW_GATE_LORA
FFN_DIM = 11 * D_MODEL // 4
IN_COLS = 3 * DA_WIDTH + RW_PROJ + 2 * D_MODEL
SPLIT_IN = (DA_WIDTH, 2 * DA_WIDTH, 3 * DA_WIDTH, 3 * DA_WIDTH + RW_PROJ, 3 * DA_WIDTH + RW_PROJ + D_MODEL)
RW_SPLIT = (RW_WIDTH, 2 * RW_WIDTH, 3 * RW_WIDTH, 3 * RW_WIDTH + RW_DECAY_LORA,
            3 * RW_WIDTH + RW_DECAY_LORA + RW_AAA_LORA)
NORM_EPS = 1e-6
SUBLN_EPS = 1e-5
LNX_EPS = 64e-5

kernel_name = "hybrid_diffattn_rwkv7_macaron_step"


def rmsnorm(x, g, eps=NORM_EPS):
    xf = x.astype(jnp.float32)
    y = xf * lax.rsqrt(jnp.mean(xf * xf, axis=-1, keepdims=True) + eps)
    return (y * g.astype(jnp.float32)).astype(x.dtype)


def swiglu(h, wi, wo):
    gate, up = jnp.split(h @ wi, 2, axis=-1)
    return (jax.nn.silu(gate) * up) @ wo


def diff_attend(q, k, v, q_pos, k_pos, lam):
    s = jnp.einsum('bqhcd,bkhcd->bhcqk', q, k).astype(jnp.float32) * (DA_HD ** -0.5)
    mask = (k_pos[None, :] // CHUNK) <= (q_pos[:, None] // CHUNK)
    s = jnp.where(mask[None, None, None], s, -jnp.inf)
    p = jax.nn.softmax(s, axis=-1)
    attn = p[:, :, 0] - lam * p[:, :, 1]
    return jnp.einsum('bhqk,bkhe->bqhe', attn.astype(v.dtype), v)


def diff_attn_prompt(q, k, v, lam):
    B, S = q.shape[0], q.shape[1]
    nblk = S // QBLOCK
    qb = jnp.moveaxis(q.reshape(B, nblk, QBLOCK, DA_HEADS, 2, DA_HD), 1, 0)
    starts = jnp.arange(nblk, dtype=jnp.int32) * QBLOCK
    k_pos = jnp.arange(S, dtype=jnp.int32)

    def one_block(args):
        qi, st = args
        return diff_attend(qi, k, v, st + jnp.arange(QBLOCK, dtype=jnp.int32), k_pos, lam)

    o = lax.map(one_block, (qb, starts))
    return jnp.moveaxis(o, 0, 1).reshape(B, S, DA_HEADS, 2 * DA_HD)


def diff_post(o, g, lam_init):
    of = o.astype(jnp.float32)
    of = of * lax.rsqrt(jnp.mean(of * of, axis=-1, keepdims=True) + SUBLN_EPS)
    of = of * g.astype(jnp.float32) * (1.0 - lam_init)
    return of.astype(o.dtype).reshape(o.shape[0], o.shape[1], DA_WIDTH)


def rwkv7_mix(u, prev, s0, mu, w0, w2, a0, a2, g2, k_k, k_a, r_k, lnx_g, lnx_b):
    B, T = u.shape[0], u.shape[1]
    f32 = jnp.float32
    u_prev = jnp.concatenate([prev.astype(u.dtype), u[:, :-1]], axis=1)
    us = u + mu * (u_prev - u)
    r, k, v, wl, al, gl = jnp.split(us, RW_SPLIT, axis=-1)
    w = -jax.nn.softplus(-(w0 + jnp.tanh(wl) @ w2).astype(f32)) - 0.5
    decay = jnp.exp(-jnp.exp(w))
    a = jax.nn.sigmoid((a0 + al @ a2).astype(f32))
    g = jax.nn.sigmoid(gl) @ g2

    def hd(t):
        return t.astype(f32).reshape(B, T, RW_HEADS, RW_HD)

    r_h, k_h, v_h, a_h, w_h = hd(r), hd(k), hd(v), hd(a), hd(decay)
    kk = k_h * k_k.astype(f32).reshape(RW_HEADS, RW_HD)
    kk = kk * lax.rsqrt(jnp.maximum(jnp.sum(kk * kk, axis=-1, keepdims=True), 1e-24))
    k_h = k_h * (1.0 + (a_h - 1.0) * k_a.astype(f32).reshape(RW_HEADS, RW_HD))

    def tm(t):
        return jnp.moveaxis(t, 1, 0)

    def step(S, xs):
        r_t, w_t, k_t, v_t, kk_t, a_t = xs
        sa = jnp.einsum('bhij,bhj->bhi', S, -kk_t)
        S = (S * w_t[:, :, None, :] + sa[..., None] * (kk_t * a_t)[:, :, None, :]
             + v_t[..., None] * k_t[:, :, None, :])
        return S, jnp.einsum('bhij,bhj->bhi', S, r_t)

    s_fin, y = lax.scan(step, s0.astype(f32), (tm(r_h), tm(w_h), tm(k_h), tm(v_h), tm(kk), tm(a_h)))
    y = jnp.moveaxis(y, 0, 1)
    mean = jnp.mean(y, axis=-1, keepdims=True)
    var = jnp.mean(jnp.square(y - mean), axis=-1, keepdims=True)
    y = (y - mean) * lax.rsqrt(var + LNX_EPS)
    y = y * lnx_g.astype(f32).reshape(RW_HEADS, RW_HD) + lnx_b.astype(f32).reshape(RW_HEADS, RW_HD)
    y = y + jnp.sum(r_h * k_h * r_k.astype(f32), axis=-1, keepdims=True) * v_h
    o = y.reshape(B, T, RW_WIDTH).astype(u.dtype) * g
    return o, s_fin.astype(s0.dtype)


def layer(x, l, past_k, past_v, rw_state, shift_prev, p):
    B, T = x.shape[0], x.shape[1]
    x = x + 0.5 * swiglu(rmsnorm(x, p['ffn1_norm']), p['ffn1_wi'], p['ffn1_wo'])
    h = rmsnorm(x, p['mix_norm'])
    u = h @ p['w_in']
    q, k, v, urw, ga, gb = jnp.split(u, SPLIT_IN, axis=-1)
    q5 = q.reshape(B, T, DA_HEADS, 2, DA_HD)
    k4 = k.reshape(B, T, DA_HEADS, 2 * DA_HD)
    v4 = v.reshape(B, T, DA_HEADS, 2 * DA_HD)
    lam_init = 0.8 - 0.6 * math.exp(-0.3 * l)
    f32 = jnp.float32
    lam = (jnp.exp(jnp.sum(p['lambda_q1'].astype(f32) * p['lambda_k1'].astype(f32)))
           - jnp.exp(jnp.sum(p['lambda_q2'].astype(f32) * p['lambda_k2'].astype(f32))) + lam_init)
    if past_k is None:
        o_a = diff_attn_prompt(q5, k4.reshape(B, T, DA_HEADS, 2, DA_HD), v4, lam)
        s0 = jnp.zeros((B, RW_HEADS, RW_HD, RW_HD), jnp.float32)
        prev = jnp.zeros((B, 1, RW_PROJ), u.dtype)
    else:
        P = past_k.shape[1]
        k_all = jnp.concatenate([past_k.astype(k4.dtype), k4], axis=1)
        v_all = jnp.concatenate([past_v.astype(v4.dtype), v4], axis=1)
        o_a = diff_attend(q5, k_all.reshape(B, P + T, DA_HEADS, 2, DA_HD), v_all,
                          P + jnp.arange(T, dtype=jnp.int32), jnp.arange(P + T, dtype=jnp.int32), lam)
        s0 = rw_state
        prev = shift_prev
    o_a = diff_post(o_a, p['subln_g'], lam_init)
    o_b, s_new = rwkv7_mix(urw, prev, s0, p['shift_mu'], p['rw_w0'], p['rw_w2'], p['rw_a0'], p['rw_a2'],
                           p['rw_g2'], p['rw_k_k'], p['rw_k_a'], p['rw_r_k'], p['rw_lnx_g'], p['rw_lnx_b'])
    merged = jax.nn.sigmoid(ga) * (o_a @ p['w_proj_a']) + jax.nn.sigmoid(gb) * (o_b @ p['w_proj_b'])
    x = x + merged @ p['w_out']
    x = x + 0.5 * swiglu(rmsnorm(x, p['ffn2_norm']), p['ffn2_wi'], p['ffn2_wo'])
    return x, k4, v4, s_new, urw[:, -1:]


def setup_inputs(seed: int = 0) -> dict:
    key = jax.random.key(seed)
    ks = jax.random.split(key, 40)
    f32 = jnp.float32
    L = DEPTH

    def nrm(k, shape, scale):
        return jax.random.normal(k, shape, f32) * scale

    inp = {}
    inp['x_prompt'] = nrm(ks[0], (BATCH, SEQ, D_MODEL), 1.0)
    inp['x_sample'] = nrm(ks[1], (DEC_BATCH, DEC_SEQ, D_MODEL), 1.0)
    inp['cache_k'] = nrm(ks[2], (L, DEC_BATCH, PAST_LEN, DA_HEADS, 2 * DA_HD), 1.0)
    inp['cache_v'] = nrm(ks[3], (L, DEC_BATCH, PAST_LEN, DA_HEADS, 2 * DA_HD), 1.0)
    inp['state_rwkv'] = nrm(ks[4], (L, DEC_BATCH, RW_HEADS, RW_HD, RW_HD), 1.0)
    inp['state_shift'] = nrm(ks[5], (L, DEC_BATCH, 1, RW_PROJ), 1.0)
    inp['ffn1_norm'] = 1.0 + nrm(ks[6], (L, D_MODEL), 0.02)
    inp['ffn1_wi'] = nrm(ks[7], (L, D_MODEL, 2 * FFN_DIM), D_MODEL ** -0.5)
    inp['ffn1_wo'] = nrm(ks[8], (L, FFN_DIM, D_MODEL), FFN_DIM ** -0.5)
    inp['mix_norm'] = 1.0 + nrm(ks[9], (L, D_MODEL), 0.02)
    inp['w_in'] = nrm(ks[10], (L, D_MODEL, IN_COLS), D_MODEL ** -0.5)
    inp['lambda_q1'] = nrm(ks[11], (L, DA_HD), 0.1)
    inp['lambda_k1'] = nrm(ks[12], (L, DA_HD), 0.1)
    inp['lambda_q2'] = nrm(ks[13], (L, DA_HD), 0.1)
    inp['lambda_k2'] = nrm(ks[14], (L, DA_HD), 0.1)
    inp['subln_g'] = 1.0 + nrm(ks[15], (L, 2 * DA_HD), 0.02)
    inp['shift_mu'] = jax.random.uniform(ks[16], (L, RW_PROJ), f32)
    inp['rw_w0'] = jnp.linspace(-6.0, -1.0, RW_WIDTH, dtype=f32)[None, :] + nrm(ks[17], (L, RW_WIDTH), 0.1)
    inp['rw_w2'] = nrm(ks[18], (L, RW_DECAY_LORA, RW_WIDTH), 0.5 * RW_DECAY_LORA ** -0.5)
    inp['rw_a0'] = nrm(ks[19], (L, RW_WIDTH), 0.1)
    inp['rw_a2'] = nrm(ks[20], (L, RW_AAA_LORA, RW_WIDTH), 0.5 * RW_AAA_LORA ** -0.5)
    inp['rw_g2'] = nrm(ks[21], (L, RW_GATE_LORA, RW_WIDTH), RW_GATE_LORA ** -0.5)
    inp['rw_k_k'] = 0.85 + nrm(ks[22], (L, RW_WIDTH), 0.05)
    inp['rw_k_a'] = 1.0 + nrm(ks[23], (L, RW_WIDTH), 0.05)
    inp['rw_r_k'] = nrm(ks[24], (L, RW_HEADS, RW_HD), 0.1)
    inp['rw_lnx_g'] = 1.0 + nrm(ks[25], (L, RW_WIDTH), 0.02)
    inp['rw_lnx_b'] = nrm(ks[26], (L, RW_WIDTH), 0.01)
    inp['w_proj_a'] = nrm(ks[27], (L, DA_WIDTH, D_MODEL), DA_WIDTH ** -0.5)
    inp['w_proj_b'] = nrm(ks[28], (L, RW_WIDTH, D_MODEL), RW_WIDTH ** -0.5)
    inp['w_out'] = nrm(ks[29], (L, D_MODEL, D_MODEL), D_MODEL ** -0.5)
    inp['ffn2_norm'] = 1.0 + nrm(ks[30], (L, D_MODEL), 0.02)
    inp['ffn2_wi'] = nrm(ks[31], (L, D_MODEL, 2 * FFN_DIM), D_MODEL ** -0.5)
    inp['ffn2_wo'] = nrm(ks[32], (L, FFN_DIM, D_MODEL), FFN_DIM ** -0.5)
    inp['final_norm'] = 1.0 + nrm(ks[33], (D_MODEL,), 0.02)
    return inp


def reference(x_prompt, x_sample, cache_k, cache_v, state_rwkv, state_shift,
              ffn1_norm, ffn1_wi, ffn1_wo, mix_norm, w_in,
              lambda_q1, lambda_k1, lambda_q2, lambda_k2, subln_g,
              shift_mu, rw_w0, rw_w2, rw_a0, rw_a2, rw_g2, rw_k_k, rw_k_a, rw_r_k, rw_lnx_g, rw_lnx_b,
              w_proj_a, w_proj_b, w_out, ffn2_norm, ffn2_wi, ffn2_wo, final_norm):
    def params(l):
        return dict(ffn1_norm=ffn1_norm[l], ffn1_wi=ffn1_wi[l], ffn1_wo=ffn1_wo[l],
                    mix_norm=mix_norm[l], w_in=w_in[l],
                    lambda_q1=lambda_q1[l], lambda_k1=lambda_k1[l],
                    lambda_q2=lambda_q2[l], lambda_k2=lambda_k2[l], subln_g=subln_g[l],
                    shift_mu=shift_mu[l], rw_w0=rw_w0[l], rw_w2=rw_w2[l], rw_a0=rw_a0[l], rw_a2=rw_a2[l],
                    rw_g2=rw_g2[l], rw_k_k=rw_k_k[l], rw_k_a=rw_k_a[l], rw_r_k=rw_r_k[l],
                    rw_lnx_g=rw_lnx_g[l], rw_lnx_b=rw_lnx_b[l],
                    w_proj_a=w_proj_a[l], w_proj_b=w_proj_b[l], w_out=w_out[l],
                    ffn2_norm=ffn2_norm[l], ffn2_wi=ffn2_wi[l], ffn2_wo=ffn2_wo[l])

    xp = x_prompt
    kp, vp, sp, shp = [], [], [], []
    for l in range(DEPTH):
        xp, k_l, v_l, s_l, sh_l = layer(xp, l, None, None, None, None, params(l))
        kp.append(k_l); vp.append(v_l); sp.append(s_l); shp.append(sh_l)
    y_prompt = rmsnorm(xp, final_norm)

    xs = x_sample
    ks_, vs_, ss_, shs_ = [], [], [], []
    for l in range(DEPTH):
        xs, k_l, v_l, s_l, sh_l = layer(xs, l, cache_k[l], cache_v[l], state_rwkv[l], state_shift[l], params(l))
        ks_.append(k_l); vs_.append(v_l); ss_.append(s_l); shs_.append(sh_l)
    y_sample = rmsnorm(xs, final_norm)

    return (y_prompt, y_sample,
            jnp.stack(kp), jnp.stack(vp), jnp.stack(sp), jnp.stack(shp),
            jnp.stack(ks_), jnp.stack(vs_), jnp.stack(ss_), jnp.stack(shs_))
```

```cpp
#include <hip/hip_runtime.h>
#include <hip/hip_bf16.h>
#include <cstdio>
#include <cstdint>
constexpr int MROWS = 34816, MP = 32768, DM = 2048, FFD = 5632;
constexpr size_t OFF_YP = 0, OFF_YS = 67108864, OFF_KP = 71303168, OFF_VP = 104857600, OFF_SRP = 138412032, OFF_SHP = 138674176,
                 OFF_KS = 138688256, OFF_VS = 140785408, OFF_SRS = 142882560, OFF_SHS = 144979712, OUT_TOTAL = 145092352;
constexpr float QSCALE = 0.125f * 1.4426950408889634f;
namespace pg8 {
#define PG8_LAS __attribute__((address_space(3)))
typedef unsigned short bf16_t;
typedef short bf16x8 __attribute__((ext_vector_type(8)));
typedef float f32x4 __attribute__((ext_vector_type(4)));
typedef unsigned u32x4 __attribute__((ext_vector_type(4)));
constexpr int BM = 256, BK = 64, HALF = 128, HTB = HALF * BK * 2  , STAGE_BYTES = 8 * HTB, NXCD = 8, WGM = 8;

__host__ __device__ __forceinline__ int lds_byte(int r, int c) { const int st = (r >> 4) * 2 + (c >> 5), rr = r & 15, cc = c & 31, ob = rr * 64 + cc * 2; return st * 1024 + (ob ^ (((ob >> 9) & 1) << 5)); }
__host__ __device__ __forceinline__ void stage_rc(int b, int& R, int& C) { const int st = b / 1024, sb = b % 1024, swz = sb ^ (((sb >> 9) & 1) << 5); R = (st >> 1) * 16 + swz / 64; C = (st & 1) * 32 + (swz % 64) / 2; }
__host__ __device__ __forceinline__ int perm32(int rho) { const int n = rho >> 4, i = rho & 15; return 8 * (i >> 2) + 4 * n + (i & 3); }

struct Unit { int pm, pn, oa; };
struct Gemm { const bf16_t* A; const bf16_t* Bt; int M, N, K, lda; };

struct StaticOrder {
    int nM, nN, nwg, G, c;
    __host__ __device__ void init(int M, int N, int G_, int c_) { nM = M / BM; nN = N / BM; nwg = nM * nN; G = G_; c = c_; }
    __host__ __device__ bool next(int i, Unit& u) const {
        const long L = (long)i * G + c; if (L >= nwg) return false;
        int wgid = (int)L; { const int q = nwg / NXCD, r = nwg % NXCD, xcd = wgid % NXCD, off = wgid / NXCD; wgid = (xcd < r ? xcd * (q + 1) : r * (q + 1) + (xcd - r) * q) + off; }
        const int nig = WGM * nN, gid = wgid / nig, fm = gid * WGM, gsz = (nM - fm) < WGM ? (nM - fm) : WGM;
        u.pm = fm + ((wgid % nig) % gsz); u.pn = (wgid % nig) / gsz; u.oa = 0; return true;
    }
    __device__ __forceinline__ void a_ready(const Unit&) const {}
    __device__ __forceinline__ void done(const Unit&) const {}
};

typedef float f32x2_cv __attribute__((ext_vector_type(2))); typedef __bf16 bf16x2_cv __attribute__((ext_vector_type(2)));
__device__ __forceinline__ unsigned cvt_pk_bf16(float lo, float hi) { f32x2_cv v = {lo, hi}; bf16x2_cv b = __builtin_convertvector(v, bf16x2_cv); return __builtin_bit_cast(unsigned, b); }
typedef unsigned u32x2 __attribute__((ext_vector_type(2)));
__device__ __forceinline__ float bf_lo(unsigned w) { return __uint_as_float(w << 16); }
__device__ __forceinline__ float bf_hi(unsigned w) { return __uint_as_float(w & 0xffff0000u); }
__device__ __forceinline__ float sigm(float x) { return __builtin_amdgcn_rcpf(1.0f + __expf(-x)); }
__device__ __forceinline__ u32x4 pack8(const float* o) { u32x4 w; w.x = cvt_pk_bf16(o[0], o[1]); w.y = cvt_pk_bf16(o[2], o[3]); w.z = cvt_pk_bf16(o[4], o[5]); w.w = cvt_pk_bf16(o[6], o[7]); return w; }

struct EpiSwiGLU {
    static constexpr bool PERM = true, AFTER_DRAIN = false;
    bf16_t* O; const float* ss;
    __device__ __forceinline__ void operator()(const f32x4 (&acc)[2][2][4][2], const Unit& u, int wr, int wc, int fr, int fq) const {
        const int row0 = u.pm * BM + wr * 64 + fr, col0 = u.pn * HALF + wc * 32 + 8 * fq;
        float rsv[8];
#pragma unroll
        for (int g = 0; g < 8; ++g) rsv[g] = ss[row0 + (g >> 2) * HALF + (g & 3) * 16];
        asm volatile("" : "+v"(rsv[0]), "+v"(rsv[1]), "+v"(rsv[2]), "+v"(rsv[3]), "+v"(rsv[4]), "+v"(rsv[5]), "+v"(rsv[6]), "+v"(rsv[7]));
#pragma unroll
        for (int ai = 0; ai < 2; ++ai)
#pragma unroll
            for (int m = 0; m < 4; ++m) {
                const int row = row0 + ai * HALF + m * 16;
                const float rs = rsqrtf(rsv[ai * 4 + m] * (1.0f / 2048.0f) + 1e-6f);
                float o[8];
#pragma unroll
                for (int n = 0; n < 2; ++n)
#pragma unroll
                    for (int e = 0; e < 4; ++e) { const float g = acc[ai][0][m][n][e] * rs, up = acc[ai][1][m][n][e] * rs; o[4 * n + e] = g * sigm(g) * up; }
                *(u32x4*)(O + (size_t)row * FFD + col0) = pack8(o);
            }
    }
};
template <bool IN_BF16, bool OUT_BF16> struct EpiResid {
    static constexpr bool PERM = true, AFTER_DRAIN = false;
    const float* xp; const float* xs; const bf16_t* xin_b; float* xo; bf16_t* xb; float* ss; float scale;
    __device__ __forceinline__ void operator()(const f32x4 (&acc)[2][2][4][2], const Unit& u, int wr, int wc, int fr, int fq) const {
        const int row0 = u.pm * BM + wr * 64 + fr, col0 = u.pn * BM + wc * 32 + 8 * fq;
        f32x4 xi[8][4]; u32x4 xw[8][2];
#define RES_LOAD(g) do { const int row_ = row0 + ((g) >> 2) * HALF + ((g) & 3) * 16; \
        if (IN_BF16) { const bf16_t* xin_ = xin_b + (size_t)row_ * DM; xw[g][0] = *(const u32x4*)(xin_ + col0); xw[g][1] = *(const u32x4*)(xin_ + col0 + HALF); } \
        else { const float* xin_ = (row_ < MP) ? xp + (size_t)row_ * DM : xs + (size_t)(row_ - MP) * DM; \
               xi[g][0] = *(const f32x4*)(xin_ + col0); xi[g][1] = *(const f32x4*)(xin_ + col0 + 4); xi[g][2] = *(const f32x4*)(xin_ + col0 + HALF); xi[g][3] = *(const f32x4*)(xin_ + col0 + HALF + 4); } } while (0)
        RES_LOAD(0); RES_LOAD(1);
#pragma unroll
        for (int g = 0; g < 8; ++g) {
            const int ai = g >> 2, m = g & 3, row = row0 + ai * HALF + m * 16;
            float sq = 0.f;
#pragma unroll
            for (int bj = 0; bj < 2; ++bj) {
                const int col = col0 + bj * HALF;
                float o[8];
                if (IN_BF16) { const u32x4 w = xw[g][bj]; o[0] = bf_lo(w.x); o[1] = bf_hi(w.x); o[2] = bf_lo(w.y); o[3] = bf_hi(w.y); o[4] = bf_lo(w.z); o[5] = bf_hi(w.z); o[6] = bf_lo(w.w); o[7] = bf_hi(w.w); }
                else { const f32x4 a0 = xi[g][2 * bj], a1 = xi[g][2 * bj + 1]; o[0] = a0[0]; o[1] = a0[1]; o[2] = a0[2]; o[3] = a0[3]; o[4] = a1[0]; o[5] = a1[1]; o[6] = a1[2]; o[7] = a1[3]; }
#pragma unroll
                for (int e = 0; e < 8; ++e) o[e] += acc[ai][bj][m][e >> 2][e & 3] * scale;
                if (OUT_BF16) *(u32x4*)(xb + (size_t)row * DM + col) = pack8(o);
                else { float* xout = xo + (size_t)row * DM + col; *(f32x4*)xout = (f32x4){o[0], o[1], o[2], o[3]}; *(f32x4*)(xout + 4) = (f32x4){o[4], o[5], o[6], o[7]}; }
#pragma unroll
                for (int e = 0; e < 8; ++e) sq += o[e] * o[e];
            }
            sq += __shfl_xor(sq, 16); sq += __shfl_xor(sq, 32);
            if (fq == 0) atomicAdd(ss + row, sq);
            if (g == 0) RES_LOAD(2); if (g == 1) RES_LOAD(3); if (g == 2) RES_LOAD(4); if (g == 3) RES_LOAD(5); if (g == 4) RES_LOAD(6); if (g == 5) RES_LOAD(7);
        }
#undef RES_LOAD
    }
};
struct EpiWin {
    static constexpr bool PERM = true, AFTER_DRAIN = false;
    const float* ss; bf16_t* QB; bf16_t* KB; bf16_t* VB; float* dout; bf16_t* U; bf16_t* GA; bf16_t* GB;
    __device__ __forceinline__ void operator()(const f32x4 (&acc)[2][2][4][2], const Unit& u, int wr, int wc, int fr, int fq) const {
        const int pn = u.pn, row0 = u.pm * BM + wr * 64 + fr, cl = wc * 32 + 8 * fq;
        float rsv[8];
#pragma unroll
        for (int g = 0; g < 8; ++g) rsv[g] = ss[row0 + (g >> 2) * HALF + (g & 3) * 16];
        asm volatile("" : "+v"(rsv[0]), "+v"(rsv[1]), "+v"(rsv[2]), "+v"(rsv[3]), "+v"(rsv[4]), "+v"(rsv[5]), "+v"(rsv[6]), "+v"(rsv[7]));
#pragma unroll
        for (int ai = 0; ai < 2; ++ai)
#pragma unroll
            for (int m = 0; m < 4; ++m) {
                const int row = row0 + ai * HALF + m * 16;
                const float rs = rsqrtf(rsv[ai * 4 + m] * (1.0f / 2048.0f) + 1e-6f);
#pragma unroll
                for (int bj = 0; bj < 2; ++bj) {
                    const int c = cl + bj * HALF;
                    float o[8];
#pragma unroll
                    for (int n = 0; n < 2; ++n)
#pragma unroll
                        for (int e = 0; e < 4; ++e) o[4 * n + e] = acc[ai][bj][m][n][e] * rs;
                    if (pn < 4) {
#pragma unroll
                        for (int e = 0; e < 8; ++e) o[e] *= QSCALE;
                        *(u32x4*)(QB + (size_t)row * 1024 + pn * 256 + c) = pack8(o);
                    } else if (pn < 12) {
                        const bool isk = pn < 8; const int col = (isk ? pn - 4 : pn - 8) * 256 + c;
                        float* fo = (row < MP) ? dout + (isk ? OFF_KP : OFF_VP) + (size_t)row * 1024 + col : dout + (isk ? OFF_KS : OFF_VS) + (size_t)(row - MP) * 1024 + col;
                        *(f32x4*)fo = (f32x4){o[0], o[1], o[2], o[3]}; *(f32x4*)(fo + 4) = (f32x4){o[4], o[5], o[6], o[7]};
                        if (row < MP) *(u32x4*)((isk ? KB : VB) + (size_t)row * 1024 + col) = pack8(o);
                    } else if (pn < 26) {
                        const int col = (pn - 12) * 256 + c;
                        *(u32x4*)(U + (size_t)row * 3584 + col) = pack8(o);
                        if (col < 3520) {
                            float* so = nullptr;
                            if (row < MP) { if ((row & 8191) == 8191) so = dout + OFF_SHP + (size_t)(row >> 13) * 3520 + col; }
                            else { if (((row - MP) & 63) == 63) so = dout + OFF_SHS + (size_t)((row - MP) >> 6) * 3520 + col; }
                            if (so) { *(f32x4*)so = (f32x4){o[0], o[1], o[2], o[3]}; *(f32x4*)(so + 4) = (f32x4){o[4], o[5], o[6], o[7]}; }
                        }
                    } else {
                        const bool isa = pn < 34; const int col = (isa ? pn - 26 : pn - 34) * 256 + c;
#pragma unroll
                        for (int e = 0; e < 8; ++e) o[e] = sigm(o[e]);
                        *(u32x4*)((isa ? GA : GB) + (size_t)row * DM + col) = pack8(o);
                    }
                }
            }
    }
};
struct EpiLora {
    static constexpr bool PERM = true, AFTER_DRAIN = false;
    const float* w0; const float* a0; bf16_t* LW; bf16_t* AS; bf16_t* GG;
    __device__ __forceinline__ void operator()(const f32x4 (&acc)[2][2][4][2], const Unit& u, int wr, int wc, int fr, int fq) const {
        const int pn = u.pn, row0 = u.pm * BM + wr * 64 + fr, cl = wc * 32 + 8 * fq;
        f32x4 bias[2][2];
#pragma unroll
        for (int bj = 0; bj < 2; ++bj) { const int col = (pn & 3) * 256 + cl + bj * HALF; const float* bp = (pn < 4) ? w0 + col : a0 + col;
            if (pn < 8) { bias[bj][0] = *(const f32x4*)bp; bias[bj][1] = *(const f32x4*)(bp + 4); } else { bias[bj][0] = (f32x4){0.f, 0.f, 0.f, 0.f}; bias[bj][1] = bias[bj][0]; } }
#pragma unroll
        for (int ai = 0; ai < 2; ++ai)
#pragma unroll
            for (int m = 0; m < 4; ++m) {
                const int row = row0 + ai * HALF + m * 16;
#pragma unroll
                for (int bj = 0; bj < 2; ++bj) {
                    const int col = (pn & 3) * 256 + cl + bj * HALF;
                    float o[8];
#pragma unroll
                    for (int n = 0; n < 2; ++n)
#pragma unroll
                        for (int e = 0; e < 4; ++e) o[4 * n + e] = acc[ai][bj][m][n][e] + bias[bj][n][e];
                    if (pn < 4) {
#pragma unroll
                        for (int e = 0; e < 8; ++e) { const float wv = -__logf(1.0f + __expf(-o[e])) - 0.5f; o[e] = -__expf(wv); }
                        *(u32x4*)(LW + (size_t)row * 1024 + col) = pack8(o);
                    } else if (pn < 8) {
#pragma unroll
                        for (int e = 0; e < 8; ++e) o[e] = sigm(o[e]);
                        *(u32x4*)(AS + (size_t)row * 1024 + col) = pack8(o);
                    } else {
                        *(u32x4*)(GG + (size_t)row * 1024 + col) = pack8(o);
                    }
                }
            }
    }
};
template <bool ADD> struct EpiProj {
    static constexpr bool PERM = true, AFTER_DRAIN = false;
    const bf16_t* GT; bf16_t* MG;
    __device__ __forceinline__ void operator()(const f32x4 (&acc)[2][2][4][2], const Unit& u, int wr, int wc, int fr, int fq) const {
        const int row0 = u.pm * BM + wr * 64 + fr, col0 = u.pn * BM + wc * 32 + 8 * fq;
        u32x4 gi[8][2], pi[8][2];
#define PRJ_LOAD(g) do { const size_t off_ = (size_t)(row0 + ((g) >> 2) * HALF + ((g) & 3) * 16) * DM + col0; gi[g][0] = *(const u32x4*)(GT + off_); gi[g][1] = *(const u32x4*)(GT + off_ + HALF); \
        if (ADD) { pi[g][0] = *(const u32x4*)(MG + off_); pi[g][1] = *(const u32x4*)(MG + off_ + HALF); } } while (0)
        PRJ_LOAD(0); PRJ_LOAD(1);
#pragma unroll
        for (int g = 0; g < 8; ++g) {
            const int ai = g >> 2, m = g & 3, row = row0 + ai * HALF + m * 16;
#pragma unroll
            for (int bj = 0; bj < 2; ++bj) {
                const size_t off = (size_t)row * DM + col0 + bj * HALF;
                const u32x4 gt = gi[g][bj];
                float o[8];
#pragma unroll
                for (int n = 0; n < 2; ++n)
#pragma unroll
                    for (int e = 0; e < 4; ++e) o[4 * n + e] = acc[ai][bj][m][n][e];
                o[0] *= bf_lo(gt.x); o[1] *= bf_hi(gt.x); o[2] *= bf_lo(gt.y); o[3] *= bf_hi(gt.y); o[4] *= bf_lo(gt.z); o[5] *= bf_hi(gt.z); o[6] *= bf_lo(gt.w); o[7] *= bf_hi(gt.w);
                if (ADD) { const u32x4 p = pi[g][bj];
                    o[0] += bf_lo(p.x); o[1] += bf_hi(p.x); o[2] += bf_lo(p.y); o[3] += bf_hi(p.y); o[4] += bf_lo(p.z); o[5] += bf_hi(p.z); o[6] += bf_lo(p.w); o[7] += bf_hi(p.w); }
                *(u32x4*)(MG + off) = pack8(o);
            }
            if (g == 0) PRJ_LOAD(2); if (g == 1) PRJ_LOAD(3); if (g == 2) PRJ_LOAD(4); if (g == 3) PRJ_LOAD(5); if (g == 4) PRJ_LOAD(6); if (g == 5) PRJ_LOAD(7);
        }
#undef PRJ_LOAD
    }
};

struct PanelOrder {
    int c, mode;
    __device__ __forceinline__ bool next(int i, Unit& u) const {
        if (mode == 0) { if (i >= 4) return false; const int x = c & 7, s = c >> 3; u.pm = i * 32 + x * 4 + (s >> 3); u.pn = s & 7; u.oa = 0; return true; }
        if (i >= 1 || c >= 64) return false; u.pm = 128 + (c & 7); u.pn = c >> 3; u.oa = 0; return true;
    }
    __device__ __forceinline__ void a_ready(const Unit&) const {}
    __device__ __forceinline__ void done(const Unit&) const {}
};
struct RangeOrder {
    int nM, nN, q, x, s, ns, base, cnt;
    __device__ __forceinline__ bool next(int i, Unit& u) const {
        const int j = s + ns * i; if (s < 0 || j >= cnt) return false;
        const int wgid = x * q + base + j, nig = WGM * nN, gid = wgid / nig, fm = gid * WGM, gsz = (nM - fm) < WGM ? (nM - fm) : WGM;
        u.pm = fm + ((wgid % nig) % gsz); u.pn = (wgid % nig) / gsz; u.oa = 0; return true;
    }
    __device__ __forceinline__ void a_ready(const Unit&) const {}
    __device__ __forceinline__ void done(const Unit&) const {}
};
struct LoraOrder {
    StaticOrder so;
    __device__ __forceinline__ bool next(int i, Unit& u) const { if (!so.next(i, u)) return false; u.oa = (u.pn >> 2) * (MROWS * 256 * 2); return true; }
    __device__ __forceinline__ void a_ready(const Unit&) const {}
    __device__ __forceinline__ void done(const Unit&) const {}
};
template <class Epi, class Sched, bool ALIGN_EPI = false, bool SP2 = false>
__device__ __forceinline__ void gemm_phase(PG8_LAS unsigned char* lds, const Gemm g, const Sched& S, const Epi& E) {
    const int tid = threadIdx.x, wid = __builtin_amdgcn_readfirstlane(tid >> 6), lane = tid & 63, wr = wid >> 2, wc = wid & 3, fr = lane & 15, fq = lane >> 4;
    const int K = g.K, nt = K / BK, lda = K;
    unsigned voffA[2], voffB[2];
#pragma unroll
    for (int i = 0; i < 2; ++i) { int R, C; stage_rc(tid * 16 + i * 8192, R, C); const int Rb = Epi::PERM ? ((R & ~31) + perm32(R & 31)) : R;
        voffA[i] = (unsigned)(R * lda + C) * 2u; voffB[i] = (unsigned)(Rb * K + C) * 2u; }
    const size_t kstep = (size_t)(BK * 2);
    const size_t hstep = (size_t)HALF * K * 2;
    const size_t tstep = 2 * hstep;
    const size_t hstepA = (size_t)HALF * lda * 2, tstepA = 2 * hstepA;
    const unsigned ldsw = (unsigned)wid * 1024u;
    const int aoff = lds_byte(wr * 64 + fr, fq * 8), boff = lds_byte(wc * 32 + fr, fq * 8);
#define PG8_SA(b, h) (((b) * 2 + (h)) * HTB)
#define PG8_SB(b, h) ((4 + (b) * 2 + (h)) * HTB)
#define PG8_STAGE(bufoff, gbase, voff) do { _Pragma("unroll") for (int _i = 0; _i < 2; ++_i) \
        __builtin_amdgcn_global_load_lds((const unsigned*)((const char*)(gbase) + (voff)[_i]), (PG8_LAS unsigned*)(lds + (bufoff) + ldsw + _i * 8192), 16, 0, 0); } while (0)
#define PG8_LDA(dst, b, h) do { _Pragma("unroll") for (int m = 0; m < 4; ++m) _Pragma("unroll") for (int k = 0; k < 2; ++k) dst[m][k] = *(const PG8_LAS bf16x8*)(lds + PG8_SA(b, h) + aoff + m * 2048 + k * 1024); } while (0)
#define PG8_LDB(dst, b, h) do { _Pragma("unroll") for (int n = 0; n < 2; ++n) _Pragma("unroll") for (int k = 0; k < 2; ++k) dst[n][k] = *(const PG8_LAS bf16x8*)(lds + PG8_SB(b, h) + boff + n * 2048 + k * 1024); } while (0)
#define PG8_MMA(ai, bj, At, Bt) do { __builtin_amdgcn_s_setprio(1); _Pragma("unroll") for (int m = 0; m < 4; ++m) _Pragma("unroll") for (int n = 0; n < 2; ++n) _Pragma("unroll") for (int k = 0; k < 2; ++k) \
        acc[ai][bj][m][n] = __builtin_amdgcn_mfma_f32_16x16x32_bf16(Bt[n][k], At[m][k], acc[ai][bj][m][n], 0, 0, 0); __builtin_amdgcn_s_setprio(0); } while (0)
#define PG8_WAIT_V(n) asm volatile("s_waitcnt vmcnt(" #n ")" ::: "memory")
#define PG8_WAIT_L(n) asm volatile("s_waitcnt lgkmcnt(" #n ")" ::: "memory")
#define PG8_BAR __builtin_amdgcn_s_barrier()
#define PG8_SCHED __builtin_amdgcn_sched_barrier(0)
    Unit cur, nxt; int ui = 0;
    if (!S.next(0, cur)) return;
    f32x4 acc[2][2][4][2];
#pragma unroll
    for (int a = 0; a < 2; ++a)
#pragma unroll
        for (int b = 0; b < 2; ++b)
#pragma unroll
            for (int m = 0; m < 4; ++m)
#pragma unroll
                for (int n = 0; n < 2; ++n) acc[a][b][m][n] = (f32x4){0.f, 0.f, 0.f, 0.f};
    bf16x8 At[4][2], B0[2][2], B1[2][2];
    const char* cA = (const char*)g.A + (size_t)cur.pm * tstepA + cur.oa; const char* cB = (const char*)g.Bt + (size_t)cur.pn * tstep;
    S.a_ready(cur);
    if constexpr (SP2) {
        PG8_STAGE(PG8_SB(0, 0), cB, voffB); PG8_STAGE(PG8_SB(0, 1), cB + hstep, voffB); PG8_STAGE(PG8_SA(0, 0), cA, voffA); PG8_STAGE(PG8_SA(0, 1), cA + hstepA, voffA);
        if (wr == 1) PG8_BAR;
        PG8_WAIT_V(2); PG8_BAR;
        PG8_STAGE(PG8_SB(1, 0), cB + kstep, voffB); PG8_STAGE(PG8_SA(1, 0), cA + kstep, voffA); PG8_STAGE(PG8_SB(1, 1), cB + hstep + kstep, voffB);
        PG8_WAIT_V(6); PG8_BAR;
    } else {
        PG8_STAGE(PG8_SB(0, 0), cB, voffB); PG8_STAGE(PG8_SA(0, 0), cA, voffA); PG8_STAGE(PG8_SB(0, 1), cB + hstep, voffB); PG8_STAGE(PG8_SA(0, 1), cA + hstepA, voffA);
        if (wr == 1) PG8_BAR;
        PG8_WAIT_V(4); PG8_BAR;
        PG8_STAGE(PG8_SB(1, 0), cB + kstep, voffB); PG8_STAGE(PG8_SA(1, 0), cA + kstep, voffA); PG8_STAGE(PG8_SB(1, 1), cB + hstep + kstep, voffB);
        PG8_WAIT_V(6); PG8_BAR;
    }
    for (;;) {
        const bool has_next = S.next(ui + 1, nxt);
        const char* nA = has_next ? (const char*)g.A + (size_t)nxt.pm * tstepA + nxt.oa : cA; const char* nB = has_next ? (const char*)g.Bt + (size_t)nxt.pn * tstep : cB;
#pragma unroll 1
        for (int t = 0; t < nt; t += 2) {
            const bool last = (t == nt - 2);
            const char* a1 = cA + (size_t)(t + 1) * kstep;
            const char* a2 = last ? nA : cA + (size_t)(t + 2) * kstep; const char* b2 = last ? nB : cB + (size_t)(t + 2) * kstep;
            const char* a3 = a2 + kstep; const char* b3 = b2 + kstep;
            if (last && has_next) S.a_ready(nxt);
            if constexpr (SP2) {
            PG8_LDB(B0, 0, 0); PG8_LDB(B1, 0, 1); PG8_SCHED; PG8_LDA(At, 0, 0); PG8_STAGE(PG8_SA(1, 1), a1 + hstepA, voffA);
            PG8_WAIT_V(8); PG8_WAIT_L(0); PG8_BAR; PG8_MMA(0, 0, At, B0); PG8_MMA(0, 1, At, B1); PG8_BAR; PG8_SCHED;
            PG8_LDA(At, 0, 1); PG8_STAGE(PG8_SB(0, 0), b2, voffB); PG8_STAGE(PG8_SB(0, 1), b2 + hstep, voffB); PG8_STAGE(PG8_SA(0, 0), a2, voffA);
            PG8_WAIT_V(8); PG8_WAIT_L(0); PG8_BAR; PG8_MMA(1, 0, At, B0); PG8_MMA(1, 1, At, B1); PG8_BAR; PG8_SCHED;
            PG8_LDB(B0, 1, 0); PG8_LDB(B1, 1, 1); PG8_SCHED; PG8_LDA(At, 1, 0); PG8_STAGE(PG8_SA(0, 1), a2 + hstepA, voffA);
            PG8_WAIT_V(8); PG8_WAIT_L(0); PG8_BAR; PG8_MMA(0, 0, At, B0); PG8_MMA(0, 1, At, B1); PG8_BAR; PG8_SCHED;
            PG8_LDA(At, 1, 1); PG8_STAGE(PG8_SB(1, 0), b3, voffB); PG8_STAGE(PG8_SB(1, 1), b3 + hstep, voffB); PG8_STAGE(PG8_SA(1, 0), a3, voffA);
            PG8_WAIT_V(8); PG8_WAIT_L(0); PG8_BAR; PG8_MMA(1, 0, At, B0); PG8_MMA(1, 1, At, B1); PG8_BAR; PG8_SCHED;
            } else {
            PG8_LDB(B0, 0, 0); PG8_SCHED; PG8_LDA(At, 0, 0); PG8_STAGE(PG8_SA(1, 1), a1 + hstepA, voffA);
            PG8_WAIT_L(8); PG8_BAR; PG8_WAIT_L(0); PG8_MMA(0, 0, At, B0); PG8_BAR; PG8_SCHED;
            PG8_LDB(B1, 0, 1); PG8_STAGE(PG8_SB(0, 0), b2, voffB);
            PG8_BAR; PG8_WAIT_L(0); PG8_MMA(0, 1, At, B1); PG8_BAR;
            PG8_LDA(At, 0, 1); PG8_STAGE(PG8_SA(0, 0), a2, voffA);
            PG8_BAR; PG8_WAIT_L(0); PG8_MMA(1, 0, At, B0); PG8_BAR; PG8_SCHED;
            PG8_STAGE(PG8_SB(0, 1), b2 + hstep, voffB);
            PG8_WAIT_V(6); PG8_BAR; PG8_MMA(1, 1, At, B1); PG8_BAR;
            PG8_LDB(B0, 1, 0); PG8_SCHED; PG8_LDA(At, 1, 0); PG8_STAGE(PG8_SA(0, 1), a2 + hstepA, voffA);
            PG8_WAIT_L(8); PG8_BAR; PG8_WAIT_L(0); PG8_MMA(0, 0, At, B0); PG8_BAR; PG8_SCHED;
            PG8_LDB(B1, 1, 1); PG8_STAGE(PG8_SB(1, 0), b3, voffB);
            PG8_BAR; PG8_WAIT_L(0); PG8_MMA(0, 1, At, B1); PG8_BAR;
            PG8_LDA(At, 1, 1); PG8_STAGE(PG8_SA(1, 0), a3, voffA);
            PG8_BAR; PG8_WAIT_L(0); PG8_MMA(1, 0, At, B0); PG8_BAR; PG8_SCHED;
            PG8_STAGE(PG8_SB(1, 1), b3 + hstep, voffB);
            PG8_WAIT_V(6); PG8_BAR; PG8_MMA(1, 1, At, B1); PG8_BAR;
            }
        }
        if constexpr (ALIGN_EPI) { if (wr == 0) PG8_BAR; }
        if constexpr (!Epi::AFTER_DRAIN) { E(acc, cur, wr, wc, fr, fq); S.done(cur); }
        if (!has_next) break;
#pragma unroll
        for (int a = 0; a < 2; ++a)
#pragma unroll
            for (int b = 0; b < 2; ++b)
#pragma unroll
                for (int m = 0; m < 4; ++m)
#pragma unroll
                    for (int n = 0; n < 2; ++n) acc[a][b][m][n] = (f32x4){0.f, 0.f, 0.f, 0.f};
        cur = nxt; cA = nA; cB = nB; ++ui;
        if constexpr (ALIGN_EPI) { if (wr == 1) PG8_BAR; }
    }
    PG8_WAIT_V(0);
    if constexpr (!ALIGN_EPI) { if (wr == 0) PG8_BAR; }
    PG8_BAR;
    if constexpr (Epi::AFTER_DRAIN) { E.fused(acc, cur, wr, wc, fr, fq, lds, wid, lane); S.done(cur); }
#undef PG8_SA
#undef PG8_SB
#undef PG8_STAGE
#undef PG8_LDA
#undef PG8_LDB
#undef PG8_MMA
#undef PG8_WAIT_V
#undef PG8_WAIT_L
#undef PG8_BAR
#undef PG8_SCHED
}
}
#define LAS __attribute__((address_space(3)))
#define GAS __attribute__((address_space(1)))
typedef unsigned short bf16_t;
typedef short bf16x8 __attribute__((ext_vector_type(8)));
typedef short s16x4 __attribute__((ext_vector_type(4)));
typedef float f32x4 __attribute__((ext_vector_type(4)));
typedef float f32x16 __attribute__((ext_vector_type(16)));
typedef unsigned u32x4 __attribute__((ext_vector_type(4)));
typedef unsigned u32x2 __attribute__((ext_vector_type(2)));
typedef float f32x2_t __attribute__((ext_vector_type(2)));
typedef __bf16 bf16x2_t __attribute__((ext_vector_type(2)));
__device__ __forceinline__ unsigned cvtpk(float lo, float hi) { f32x2_t v = {lo, hi}; bf16x2_t b = __builtin_convertvector(v, bf16x2_t); return __builtin_bit_cast(unsigned, b); }
__device__ __forceinline__ u32x4 pk8(const float* o) { u32x4 w; w.x = cvtpk(o[0], o[1]); w.y = cvtpk(o[2], o[3]); w.z = cvtpk(o[4], o[5]); w.w = cvtpk(o[6], o[7]); return w; }
__device__ __forceinline__ float bflo(unsigned w) { return __uint_as_float(w << 16); }
__device__ __forceinline__ float bfhi(unsigned w) { return __uint_as_float(w & 0xffff0000u); }
__device__ __forceinline__ void unpk8(const u32x4 w, float* o) { o[0] = bflo(w.x); o[1] = bfhi(w.x); o[2] = bflo(w.y); o[3] = bfhi(w.y); o[4] = bflo(w.z); o[5] = bfhi(w.z); o[6] = bflo(w.w); o[7] = bfhi(w.w); }
__device__ __forceinline__ int crow(int r, int hi) { return (r & 3) + 8 * (r >> 2) + 4 * hi; }
__device__ __forceinline__ float swap_add(float v) { auto rr = __builtin_amdgcn_permlane32_swap(__float_as_uint(v), __float_as_uint(v), false, false); return __uint_as_float(rr[0]) + __uint_as_float(rr[1]); }
__device__ __forceinline__ float swap_max(float v) { auto rr = __builtin_amdgcn_permlane32_swap(__float_as_uint(v), __float_as_uint(v), false, false); return fmaxf(__uint_as_float(rr[0]), __uint_as_float(rr[1])); }
#define WG_BAR() do { asm volatile("s_waitcnt lgkmcnt(0)" ::: "memory"); __builtin_amdgcn_s_barrier(); asm volatile("" ::: "memory"); } while (0)
typedef short v4i16_t __attribute__((ext_vector_type(4)));
typedef unsigned long long u64x2 __attribute__((ext_vector_type(2)));
__device__ __forceinline__ unsigned long long vtr64(const LAS unsigned char* p) { return __builtin_bit_cast(unsigned long long, __builtin_amdgcn_ds_read_tr16_b64_v4i16((LAS v4i16_t*)p)); }
__device__ __forceinline__ s16x4 vtr(const LAS unsigned char* p) { return __builtin_bit_cast(s16x4, __builtin_amdgcn_ds_read_tr16_b64_v4i16((LAS v4i16_t*)p)); }

namespace att {
constexpr int KT = 16384, BUF = 32768, CBS = 132, WSF_OFF = 3 * BUF, LDS_NEED = WSF_OFF + 8 * 256;
struct Src { const void* k; const void* v; const float* kn; const float* vn; };
template <bool F32> struct Stage;
template <> struct Stage<false> { u32x4 k[2], v[2]; };
template <> struct Stage<true> { f32x4 k[2][2], v[2][2]; };

template <bool F32> __device__ __forceinline__ void tile_load(Stage<F32>& s, const Src& S, int t, int wid, int lane) {
    if constexpr (F32) {
        const float* kb = (t < 64) ? (const float*)S.k + (size_t)t * 65536 : S.kn;
        const float* vb = (t < 64) ? (const float*)S.v + (size_t)t * 65536 : S.vn;
#pragma unroll
        for (int i = 0; i < 2; ++i) { const float* p = kb + (size_t)lane * 1024 + (wid + 8 * i) * 8; s.k[i][0] = *(const f32x4*)p; s.k[i][1] = *(const f32x4*)(p + 4); }
#pragma unroll
        for (int i = 0; i < 2; ++i) { const int pp = wid + 8 * i, db = pp >> 2, kg = pp & 3; const float* p = vb + (size_t)(16 * kg + (lane >> 2)) * 1024 + db * 32 + (lane & 3) * 8; s.v[i][0] = *(const f32x4*)p; s.v[i][1] = *(const f32x4*)(p + 4); }
    } else {
        const bf16_t* kb = (const bf16_t*)S.k + (size_t)t * 65536;
        const bf16_t* vb = (const bf16_t*)S.v + (size_t)t * 65536;
#pragma unroll
        for (int i = 0; i < 2; ++i) s.k[i] = *(const u32x4*)(kb + (size_t)lane * 1024 + (wid + 8 * i) * 8);
#pragma unroll
        for (int i = 0; i < 2; ++i) { const int pp = wid + 8 * i, db = pp >> 2, kg = pp & 3; s.v[i] = *(const u32x4*)(vb + (size_t)(16 * kg + (lane >> 2)) * 1024 + db * 32 + (lane & 3) * 8); }
    }
}
template <bool F32> __device__ __forceinline__ void tile_store(const Stage<F32>& s, LAS unsigned char* buf, int wid, int lane) {
#pragma unroll
    for (int i = 0; i < 2; ++i) {
        u32x4 kv, vv;
        if constexpr (F32) { float a[8] = {s.k[i][0][0], s.k[i][0][1], s.k[i][0][2], s.k[i][0][3], s.k[i][1][0], s.k[i][1][1], s.k[i][1][2], s.k[i][1][3]}; kv = pk8(a);
                             float b[8] = {s.v[i][0][0], s.v[i][0][1], s.v[i][0][2], s.v[i][0][3], s.v[i][1][0], s.v[i][1][1], s.v[i][1][2], s.v[i][1][3]}; vv = pk8(b); }
        else { kv = s.k[i]; vv = s.v[i]; }
        *(LAS u32x4*)(buf + (wid + 8 * i) * 1024 + lane * 16) = kv;
        *(LAS u32x4*)(buf + KT + (wid + 8 * i) * 1024 + lane * 16) = vv;
    }
}

template <bool F32>
__device__ __forceinline__ void unit(LAS unsigned char* lds, const bf16_t* Qu, const Src& S, int nt_lo, int nt_hi, bf16_t* Ou, float lam, const float* subg) {
    const int tid = threadIdx.x, lane = tid & 63, wid = __builtin_amdgcn_readfirstlane(tid >> 6), r32 = lane & 31, hi = lane >> 5;
    const int c = F32 ? ((wid >> 1) & 1) : (wid >> 2), rb = F32 ? ((wid < 4) ? (wid & 1) : 2 + (wid & 1)) : (wid & 3);
    const int ntw = (rb < 2) ? nt_lo : nt_hi, NT = nt_lo > nt_hi ? nt_lo : nt_hi;
    const bool active = ntw > 0, late = c == 1;
    bf16x8 qr[4];
#pragma unroll
    for (int d0 = 0; d0 < 4; ++d0) { if (active) qr[d0] = *(const bf16x8*)(Qu + (size_t)(32 * rb + r32) * 1024 + c * 64 + d0 * 16 + hi * 8); else qr[d0] = (bf16x8){0, 0, 0, 0, 0, 0, 0, 0}; }
    float mrun = 0.f, l = 0.f;
    f32x16 o[4];
#pragma unroll
    for (int d0 = 0; d0 < 4; ++d0)
#pragma unroll
        for (int r = 0; r < 16; ++r) o[d0][r] = 0.f;
    bf16x8 pa[4];
#pragma unroll
    for (int ks = 0; ks < 4; ++ks) pa[ks] = (bf16x8){0, 0, 0, 0, 0, 0, 0, 0};
    f32x16 negm;
#pragma unroll
    for (int r = 0; r < 16; ++r) negm[r] = 0.f;
    asm volatile("" : "+v"(negm));
    LAS float* wsf = (LAS float*)(lds + WSF_OFF + wid * 256);
    Stage<F32> st;
    tile_load<F32>(st, S, 0, wid, lane);
    tile_store<F32>(st, lds, wid, lane);
    if (NT > 1) tile_load<F32>(st, S, 1, wid, lane);
    WG_BAR();
    const int vlane = ((lane >> 4) & 1) * 32 + (lane & 3) * 8 + (4 * hi + ((lane & 15) >> 2)) * 64;
#define ATT_PV(bufp) do { const LAS unsigned char* vp_ = (bufp) + KT + vlane; \
        _Pragma("unroll") for (int d0 = 0; d0 < 4; ++d0) \
            _Pragma("unroll") for (int ks = 0; ks < 4; ++ks) { \
                u64x2 vq_; vq_.x = vtr64(vp_ + d0 * 4096 + ks * 1024); vq_.y = vtr64(vp_ + d0 * 4096 + ks * 1024 + 512);     \
                o[d0] = __builtin_amdgcn_mfma_f32_32x32x16_bf16(pa[ks], __builtin_bit_cast(bf16x8, vq_), o[d0], 0, 0, 0); } } while (0)
    int b_cur = 0, b_prev = 2 * BUF, b_next = BUF;
    for (int t = 0; t <= NT; ++t) {
        if (t + 1 < NT) tile_store<F32>(st, lds + b_next, wid, lane);
        if (t + 2 < NT) tile_load<F32>(st, S, t + 2, wid, lane);
        if (late && t >= 1 && t - 1 < ntw) ATT_PV(lds + b_prev);
        if (t < ntw) {
            LAS unsigned char* buf = lds + b_cur;
            f32x16 p0, p1;
            const LAS unsigned char* kb = buf + (8 * c + hi) * 1024 + r32 * 16;
#pragma unroll
            for (int d0 = 0; d0 < 4; ++d0) {
                const bf16x8 b0 = *(const LAS bf16x8*)(kb + d0 * 2048), b1 = *(const LAS bf16x8*)(kb + d0 * 2048 + 512);
                if (d0 == 0) { p0 = __builtin_amdgcn_mfma_f32_32x32x16_bf16(b0, qr[0], negm, 0, 0, 0); p1 = __builtin_amdgcn_mfma_f32_32x32x16_bf16(b1, qr[0], negm, 0, 0, 0); }
                else { p0 = __builtin_amdgcn_mfma_f32_32x32x16_bf16(b0, qr[d0], p0, 0, 0, 0); p1 = __builtin_amdgcn_mfma_f32_32x32x16_bf16(b1, qr[d0], p1, 0, 0, 0); }
            }
            float rm = fmaxf(fmaxf(p0[0], p0[1]), p1[0]);
#pragma unroll
            for (int r = 2; r < 16; r += 2) rm = fmaxf(fmaxf(rm, p0[r]), p0[r + 1]);
            rm = fmaxf(rm, p1[1]);
#pragma unroll
            for (int r = 2; r < 16; r += 2) rm = fmaxf(fmaxf(rm, p1[r]), p1[r + 1]);
            rm = swap_max(rm);
            if (t == 0 || __any(rm > 8.0f)) {
                const float dl = (t == 0) ? rm : fmaxf(rm, 0.f), alpha = (t == 0) ? 1.0f : __builtin_amdgcn_exp2f(-dl);
                mrun += dl; l *= alpha;
#pragma unroll
                for (int r = 0; r < 16; ++r) negm[r] = -mrun;
                asm volatile("" : "+v"(negm));
                if (hi == 0) wsf[r32] = alpha;
#pragma unroll
                for (int r = 0; r < 16; ++r) { p0[r] -= dl; p1[r] -= dl; const float f = wsf[crow(r, hi)];
#pragma unroll
                    for (int d0 = 0; d0 < 4; ++d0) o[d0][r] *= f; }
            }
            float sacc = 0.f;
#pragma unroll
            for (int r = 0; r < 16; ++r) { p0[r] = __builtin_amdgcn_exp2f(p0[r]); p1[r] = __builtin_amdgcn_exp2f(p1[r]); sacc += p0[r]; asm volatile("" : "+v"(sacc)); sacc += p1[r]; asm volatile("" : "+v"(sacc)); }
            l += sacc;
            { u32x4 w;
              w.x = cvtpk(p0[0], p0[1]); w.y = cvtpk(p0[2], p0[3]); w.z = cvtpk(p0[4], p0[5]); w.w = cvtpk(p0[6], p0[7]); pa[0] = __builtin_bit_cast(bf16x8, w);
              w.x = cvtpk(p0[8], p0[9]); w.y = cvtpk(p0[10], p0[11]); w.z = cvtpk(p0[12], p0[13]); w.w = cvtpk(p0[14], p0[15]); pa[1] = __builtin_bit_cast(bf16x8, w);
              w.x = cvtpk(p1[0], p1[1]); w.y = cvtpk(p1[2], p1[3]); w.z = cvtpk(p1[4], p1[5]); w.w = cvtpk(p1[6], p1[7]); pa[2] = __builtin_bit_cast(bf16x8, w);
              w.x = cvtpk(p1[8], p1[9]); w.y = cvtpk(p1[10], p1[11]); w.z = cvtpk(p1[12], p1[13]); w.w = cvtpk(p1[14], p1[15]); pa[3] = __builtin_bit_cast(bf16x8, w); }
            if (!late) ATT_PV(buf);
        }
        WG_BAR();
        { const int tmp = b_prev; b_prev = b_cur; b_cur = b_next; b_next = tmp; }
    }
#undef ATT_PV
    if (active) {
        const float lt = swap_add(l), inv = 1.0f / lt;
        if (hi == 0) wsf[r32] = inv;
#pragma unroll
        for (int r = 0; r < 16; ++r) { const float f = wsf[crow(r, hi)];
#pragma unroll
            for (int d0 = 0; d0 < 4; ++d0) o[d0][r] *= f; }
    }
    LAS float* cb = (LAS float*)lds;
    if (active && c == 1) {
#pragma unroll
        for (int d0 = 0; d0 < 4; ++d0)
#pragma unroll
            for (int r = 0; r < 16; ++r) cb[(32 * rb + crow(r, hi)) * CBS + 32 * d0 + r32] = o[d0][r];
    }
    WG_BAR();
    if (active && c == 0) {
#pragma unroll
        for (int d0 = 0; d0 < 4; ++d0)
#pragma unroll
            for (int r = 0; r < 16; ++r) { const int idx = (32 * rb + crow(r, hi)) * CBS + 32 * d0 + r32; cb[idx] = o[d0][r] - lam * cb[idx]; }
        asm volatile("s_waitcnt lgkmcnt(0)" ::: "memory");
        const int q = 32 * rb + r32;
        f32x4 vals[16]; float ssq = 0.f;
#pragma unroll
        for (int j = 0; j < 16; ++j) { vals[j] = *(const LAS f32x4*)(cb + q * CBS + 64 * hi + 4 * j); ssq += vals[j][0] * vals[j][0] + vals[j][1] * vals[j][1] + vals[j][2] * vals[j][2] + vals[j][3] * vals[j][3]; }
        ssq = swap_add(ssq);
        const float rs = rsqrtf(ssq * (1.0f / 128.0f) + 1e-5f) * 0.8f;
#pragma unroll
        for (int j = 0; j < 16; j += 2) {
            const f32x4 g0 = *(const f32x4*)(subg + 64 * hi + 4 * j), g1 = *(const f32x4*)(subg + 64 * hi + 4 * j + 4);
            float ov[8] = {vals[j][0] * rs * g0[0], vals[j][1] * rs * g0[1], vals[j][2] * rs * g0[2], vals[j][3] * rs * g0[3],
                           vals[j + 1][0] * rs * g1[0], vals[j + 1][1] * rs * g1[1], vals[j + 1][2] * rs * g1[2], vals[j + 1][3] * rs * g1[3]};
            *(u32x4*)(Ou + (size_t)q * 1024 + 64 * hi + 4 * j) = pk8(ov);
        }
    }
    WG_BAR();
}
}
namespace rw {
constexpr int STR = 144, MAT = 64 * STR, FSTR = 68;
constexpr int O_AT = 0, O_BB = MAT, O_RT = 2 * MAT, O_KB = 3 * MAT, O_VT = 4 * MAT, O_BCT = 5 * MAT, O_KCT = 6 * MAT, O_AAK = 7 * MAT, O_ARB = 8 * MAT, O_ARK = 9 * MAT;
constexpr int O_P = 10 * MAT, O_PT = 11 * MAT, O_CS = O_P, O_GC = 12 * MAT, O_P1T = O_BB, O_Q1T = O_KB, PT_OFF = O_GC + 256, LDS_NEED = PT_OFF + 24576;
constexpr int UNIT_BYTES = 32768, UO_G = 0, UO_HT = 8192, UO_Y1 = 16384, UO_Y0 = 24576;
constexpr int NUNITS = 8704, NPROMPT_UNITS = 8192;

struct Args {
    const bf16_t* U; const bf16_t* LW; const bf16_t* AS; const bf16_t* GG; const float* mu; const float* shift_in; const float* state_in;
    const float* k_k; const float* k_a; const float* r_k; const float* lnx_g; const float* lnx_b;
    unsigned char* AOUT; bf16_t* S0; float* RK; bf16_t* OB; float* dout;
};

__device__ __forceinline__ bf16x8 frag_tr(const LAS unsigned char* img, int q, int ks, int lane) {
    const int i16 = lane & 15, g1 = (lane >> 4) & 1, hi = lane >> 5;
    const LAS unsigned char* p = img + (16 * ks + 8 * hi + (i16 >> 2)) * STR + (32 * q + 16 * g1 + 4 * (i16 & 3)) * 2;
    u64x2 v; v.x = vtr64(p); v.y = vtr64(p + 4 * STR); return __builtin_bit_cast(bf16x8, v);
}
template <bool NT = false, bool MT = false>
__device__ __forceinline__ f32x16 mm_tile(const LAS unsigned char* N, const LAS unsigned char* M, int qn, int qm, int r32, int hi, f32x16 acc) {
    const int lane = r32 + 32 * hi;
    const LAS unsigned char* pa = N + (32 * qn + r32) * STR + hi * 16;
    const LAS unsigned char* pb = M + (32 * qm + r32) * STR + hi * 16;
#pragma unroll
    for (int ks = 0; ks < 4; ++ks) {
        const bf16x8 a = NT ? frag_tr(N, qn, ks, lane) : *(const LAS bf16x8*)(pa + ks * 32);
        const bf16x8 b = MT ? frag_tr(M, qm, ks, lane) : *(const LAS bf16x8*)(pb + ks * 32);
        acc = __builtin_amdgcn_mfma_f32_32x32x16_bf16(a, b, acc, 0, 0, 0);
    }
    return acc;
}
__device__ __forceinline__ f32x16 zero16() { f32x16 z;
#pragma unroll
    for (int r = 0; r < 16; ++r) z[r] = 0.f; return z; }
__device__ __forceinline__ void shifted8(const Args& A, int row, int col, bool first, bool sample, int b, float* out) {
    float u[8], p[8];
    unpk8(*(const u32x4*)(A.U + (size_t)row * 3584 + col), u);
    if (!first) unpk8(*(const u32x4*)(A.U + (size_t)(row - 1) * 3584 + col), p);
    else if (sample) { const f32x4 a = *(const f32x4*)(A.shift_in + (size_t)b * 3520 + col), c = *(const f32x4*)(A.shift_in + (size_t)b * 3520 + col + 4); p[0] = a[0]; p[1] = a[1]; p[2] = a[2]; p[3] = a[3]; p[4] = c[0]; p[5] = c[1]; p[6] = c[2]; p[7] = c[3]; }
    else {
#pragma unroll
        for (int e = 0; e < 8; ++e) p[e] = 0.f; }
    const f32x4 m0 = *(const f32x4*)(A.mu + col), m1 = *(const f32x4*)(A.mu + col + 4);
#pragma unroll
    for (int e = 0; e < 8; ++e) { const float mv = e < 4 ? m0[e & 3] : m1[e & 3]; out[e] = u[e] + mv * (p[e] - u[e]); }
}
__device__ __forceinline__ void unit_decode(int u, int& b, int& h, int& row0, bool& sample, bool& firstchunk) {
    if (u < NPROMPT_UNITS) { const int bh = u >> 7, c = u & 127; b = bh >> 4; h = bh & 15; row0 = b * 8192 + c * 64; sample = false; firstchunk = (c == 0); }
    else { const int bh = u - NPROMPT_UNITS; b = bh >> 4; h = bh & 15; row0 = MP + b * 64; sample = true; firstchunk = true; }
}

__device__ __forceinline__ int unit_of(int w) { if (w >= NPROMPT_UNITS) return w; const int h = w & 15, c = (w >> 4) & 127, b = w >> 11; return ((b * 16 + h) << 7) + c; }
struct PrepIn { u32x4 ur, urp, uk, ukp, uv, uvp, asb, lwb; };
__device__ __forceinline__ u32x4 prev_row8(const Args& A, int row, int col) { const int rp = row > 0 ? row - 1 : 0; return *(const u32x4*)(A.U + (size_t)rp * 3584 + col); }
__device__ __forceinline__ u32x4 fix_first8(const Args& A, u32x4 prv, int col, bool first, bool sample, int b) {
    if (first) {
        if (sample) { const f32x4 a = *(const f32x4*)(A.shift_in + (size_t)b * 3520 + col), c = *(const f32x4*)(A.shift_in + (size_t)b * 3520 + col + 4);
            float p[8] = {a[0], a[1], a[2], a[3], c[0], c[1], c[2], c[3]}; prv = pk8(p); }
        else prv = (u32x4){0u, 0u, 0u, 0u};
    }
    return prv;
}
__device__ __forceinline__ void prep_load(const Args& A, int u, PrepIn& in) {
    const int tid = threadIdx.x; int b, h, row0; bool sample, firstchunk; unit_decode(u, b, h, row0, sample, firstchunk);
    const int t = tid >> 3, j0 = 8 * (tid & 7), row = row0 + t, cr = h * 64 + j0;
    const bf16_t* ur = A.U + (size_t)row * 3584 + cr;
    in.ur = *(const u32x4*)ur; in.uk = *(const u32x4*)(ur + 1024); in.uv = *(const u32x4*)(ur + 2048);
    in.urp = prev_row8(A, row, cr); in.ukp = prev_row8(A, row, 1024 + cr); in.uvp = prev_row8(A, row, 2048 + cr);
    in.lwb = *(const u32x4*)(A.LW + (size_t)row * 1024 + cr); in.asb = *(const u32x4*)(A.AS + (size_t)row * 1024 + cr);
}
__device__ __forceinline__ void mix8(const u32x4 cur, const u32x4 prv, const float* mu, float* out) {
    float u[8], p[8]; unpk8(cur, u); unpk8(prv, p);
    const f32x4 m0 = *(const f32x4*)mu, m1 = *(const f32x4*)(mu + 4);
#pragma unroll
    for (int e = 0; e < 8; ++e) { const float mv = e < 4 ? m0[e & 3] : m1[e & 3]; out[e] = u[e] + mv * (p[e] - u[e]); }
}
__device__ __forceinline__ void ld8l(const LAS float* p, float* o) { const f32x4 a = *(const LAS f32x4*)p, c = *(const LAS f32x4*)(p + 4); o[0] = a[0]; o[1] = a[1]; o[2] = a[2]; o[3] = a[3]; o[4] = c[0]; o[5] = c[1]; o[6] = c[2]; o[7] = c[3]; }
__device__ __forceinline__ void mix8l(const u32x4 cur, const u32x4 prv, const LAS float* mu, float* out) {
    float u[8], p[8], m[8]; unpk8(cur, u); unpk8(prv, p); ld8l(mu, m);
#pragma unroll
    for (int e = 0; e < 8; ++e) out[e] = u[e] + m[e] * (p[e] - u[e]);
}
__device__ __forceinline__ void ld8(const float* p, float* o) { const f32x4 a = *(const f32x4*)p, c = *(const f32x4*)(p + 4); o[0] = a[0]; o[1] = a[1]; o[2] = a[2]; o[3] = a[3]; o[4] = c[0]; o[5] = c[1]; o[6] = c[2]; o[7] = c[3]; }

__device__ __forceinline__ void stage_a(LAS unsigned char* lds, const Args& A, int u, PrepIn& in, int u_next) {
    const int tid = threadIdx.x, lane = tid & 63, wid = __builtin_amdgcn_readfirstlane(tid >> 6), r32 = lane & 31, hi = lane >> 5;
    int b, h, row0; bool sample, firstchunk; unit_decode(u, b, h, row0, sample, firstchunk);
    LAS float* CS = (LAS float*)(lds + O_CS); LAS float* GC = (LAS float*)(lds + O_GC);
    {
        const int t = tid >> 3, jg = tid & 7, j0 = 8 * jg, row = row0 + t, cr = h * 64 + j0;
        float r[8], k[8], v[8], lw[8], as[8], L[8];
        float kkp[8], kap[8], rkp[8];
        const LAS float* ptab = (const LAS float*)(lds + PT_OFF) + h * 384 + j0;
        ld8l(ptab, kkp); ld8l(ptab + 64, kap); ld8l(ptab + 128, rkp);
        const bool first = firstchunk && t == 0;
        mix8l(in.ur, fix_first8(A, in.urp, cr, first, sample, b), ptab + 192, r); mix8l(in.uk, fix_first8(A, in.ukp, 1024 + cr, first, sample, b), ptab + 256, k); mix8l(in.uv, fix_first8(A, in.uvp, 2048 + cr, first, sample, b), ptab + 320, v);
        unpk8(in.lwb, lw);
        unpk8(in.asb, as);
#define RW_PIN8(a) asm volatile("" : "+v"(a[0]), "+v"(a[1]), "+v"(a[2]), "+v"(a[3]), "+v"(a[4]), "+v"(a[5]), "+v"(a[6]), "+v"(a[7]))
        RW_PIN8(r); RW_PIN8(k); RW_PIN8(v); RW_PIN8(kkp); RW_PIN8(kap); RW_PIN8(rkp); RW_PIN8(lw); RW_PIN8(as);
#undef RW_PIN8
        asm volatile("" ::: "memory");
        if (u_next >= 0) prep_load(A, u_next, in);
        asm volatile("" ::: "memory");
#pragma unroll
        for (int e = 0; e < 8; ++e) { float x = lw[e];
            float y = __shfl_up(x, 8); if (lane >= 8) x += y; y = __shfl_up(x, 16); if (lane >= 16) x += y; y = __shfl_up(x, 32); if (lane >= 32) x += y; L[e] = x; }
        if (lane >= 56) { *(LAS f32x4*)(CS + wid * 64 + j0) = (f32x4){L[0], L[1], L[2], L[3]}; *(LAS f32x4*)(CS + wid * 64 + j0 + 4) = (f32x4){L[4], L[5], L[6], L[7]}; }
        WG_BAR();
        float LC[8];
#pragma unroll
        for (int e = 0; e < 8; ++e) LC[e] = 0.f;
#pragma unroll
        for (int w = 0; w < 8; ++w) { const f32x4 a = *(const LAS f32x4*)(CS + w * 64 + j0), c = *(const LAS f32x4*)(CS + w * 64 + j0 + 4);
            const float tot[8] = {a[0], a[1], a[2], a[3], c[0], c[1], c[2], c[3]};
#pragma unroll
            for (int e = 0; e < 8; ++e) { LC[e] += tot[e]; if (w < wid) L[e] += tot[e]; } }
        if (t == 63) {
#pragma unroll
            for (int e = 0; e < 8; ++e) GC[j0 + e] = __expf(LC[e]); }
        float kk[8], km[8], bb[8]; float ssq = 0.f, rk = 0.f;
#pragma unroll
        for (int e = 0; e < 8; ++e) { kk[e] = k[e] * kkp[e]; ssq += kk[e] * kk[e]; }
        ssq += __shfl_xor(ssq, 1); ssq += __shfl_xor(ssq, 2); ssq += __shfl_xor(ssq, 4);
        const float inv = rsqrtf(fmaxf(ssq, 1e-24f));
        float oR[8], oA[8], oK[8], oB[8], oBc[8], oKc[8];
#pragma unroll
        for (int e = 0; e < 8; ++e) {
            kk[e] *= inv; km[e] = k[e] * (1.0f + (as[e] - 1.0f) * kap[e]); bb[e] = kk[e] * as[e];
            rk += r[e] * km[e] * rkp[e];
            const float g = __expf(L[e]), gp = __expf(L[e] - lw[e]), gi = __expf(-L[e]), gc = __expf(LC[e] - L[e]);
            oR[e] = r[e] * g; oA[e] = -kk[e] * gp; oK[e] = km[e] * gi; oB[e] = bb[e] * gi;
            oBc[e] = bb[e] * gc; oKc[e] = km[e] * gc;
        }
        rk += __shfl_xor(rk, 1); rk += __shfl_xor(rk, 2); rk += __shfl_xor(rk, 4);
        if (jg == 0) A.RK[(size_t)row * 16 + h] = rk;
        *(LAS u32x4*)(lds + O_RT + t * STR + j0 * 2) = pk8(oR); *(LAS u32x4*)(lds + O_AT + t * STR + j0 * 2) = pk8(oA);
        *(LAS u32x4*)(lds + O_KB + t * STR + j0 * 2) = pk8(oK); *(LAS u32x4*)(lds + O_BB + t * STR + j0 * 2) = pk8(oB);
        *(LAS u32x4*)(lds + O_BCT + t * STR + j0 * 2) = pk8(oBc); *(LAS u32x4*)(lds + O_KCT + t * STR + j0 * 2) = pk8(oKc); *(LAS u32x4*)(lds + O_VT + t * STR + j0 * 2) = pk8(v);
    }
    WG_BAR();
    for (int job = wid; job < 16; job += 8) {
        const int prod = job >> 2, qn = (job >> 1) & 1, qm = job & 1;
        const LAS unsigned char* Nm = lds + (prod == 4 ? O_AT : (prod & 1) ? O_KB : O_BB);
        const LAS unsigned char* Mm = lds + (prod == 4 ? O_BB : (prod & 2) ? O_RT : O_AT);
        const f32x16 acc = mm_tile(Nm, Mm, qn, qm, r32, hi, zero16());
        const int ri = 32 * qm + r32, sgn = (prod == 4) ? -1 : 1, lim = (prod == 2 || prod == 3) ? 1 : 0;
        LAS unsigned char* dst = lds + (prod == 0 ? O_P : prod == 1 ? O_AAK : prod == 2 ? O_ARB : prod == 3 ? O_ARK : O_PT) + ri * STR;
#pragma unroll
        for (int g = 0; g < 4; ++g) {
            const int c0 = 32 * qn + 8 * g + 4 * hi; float o4[4];
#pragma unroll
            for (int e = 0; e < 4; ++e) { const int ci = c0 + e; o4[e] = (sgn * (ci - ri) < lim) ? acc[4 * g + e] : 0.f; }
            u32x2 w; w.x = cvtpk(o4[0], o4[1]); w.y = cvtpk(o4[2], o4[3]); *(LAS u32x2*)(dst + c0 * 2) = w;
        }
    }
    WG_BAR();
    {
        const int qm = wid >> 1, qn = wid & 1;
        LAS unsigned char* ximg = lds + (qm < 2 ? O_P1T + 32 * qm * STR : O_Q1T + 32 * (qm - 2) * STR);
        f32x16 ax;
        if (qm < 2) {
#pragma unroll
            for (int r = 0; r < 16; ++r) ax[r] = bflo((unsigned)*(const LAS unsigned short*)(lds + O_AT + (32 * qn + crow(r, hi)) * STR + (32 * qm + r32) * 2));
        } else ax = mm_tile<false, true>(lds + O_AAK, lds + O_VT, qn, qm - 2, r32, hi, zero16());
#pragma unroll
        for (int g = 0; g < 4; ++g) { u32x2 w; w.x = cvtpk(ax[4 * g], ax[4 * g + 1]); w.y = cvtpk(ax[4 * g + 2], ax[4 * g + 3]); *(LAS u32x2*)(ximg + r32 * STR + (32 * qn + 8 * g + 4 * hi) * 2) = w; }
        WG_BAR();
        const int pq = wid & 3, pqn = pq >> 1, pqm = pq & 1;
        LAS unsigned char* ximg1 = lds + (qm < 2 ? O_AT + 32 * qm * STR : O_AAK + 32 * (qm - 2) * STR);
#pragma unroll 1
        for (int step = 0; step < 6; ++step) {
            const bool rd = step & 1;
            const LAS unsigned char* xr = rd ? ximg1 : ximg; LAS unsigned char* xw = rd ? ximg : ximg1;
            const LAS unsigned char* Pr = lds + (rd ? O_PT : O_P);
            ax = mm_tile(Pr, xr, qn, 0, r32, hi, ax);
            f32x16 ap;
            if (step < 5 && wid < 4) ap = mm_tile<true, false>(Pr, Pr, pqn, pqm, r32, hi, zero16());
#pragma unroll
            for (int g = 0; g < 4; ++g) { u32x2 w; w.x = cvtpk(ax[4 * g], ax[4 * g + 1]); w.y = cvtpk(ax[4 * g + 2], ax[4 * g + 3]); *(LAS u32x2*)(xw + r32 * STR + (32 * qn + 8 * g + 4 * hi) * 2) = w; }
            if (step < 5 && wid < 4) { LAS unsigned char* pd = lds + (rd ? O_P : O_PT) + (32 * pqm + r32) * STR;
#pragma unroll
                for (int g = 0; g < 4; ++g) { u32x2 w; w.x = cvtpk(ap[4 * g], ap[4 * g + 1]); w.y = cvtpk(ap[4 * g + 2], ap[4 * g + 3]); *(LAS u32x2*)(pd + (32 * pqn + 8 * g + 4 * hi) * 2) = w; } }
            WG_BAR();
        }
    }
    {
        unsigned char* uo = A.AOUT + (size_t)u * UNIT_BYTES;
        const int q = wid & 3, qn = q >> 1, qm = q & 1, mrow = 32 * qm + r32;
        if (wid < 4) {
            f32x16 acc = mm_tile<false, true>(lds + O_P1T, lds + O_BCT, qn, qm, r32, hi, zero16());
            const float gcv = GC[mrow];
            bf16_t* Gp = (bf16_t*)(uo + UO_G) + mrow * 64;
#pragma unroll
            for (int g = 0; g < 4; ++g) { const int n0 = 32 * qn + 8 * g + 4 * hi; float o4[4];
#pragma unroll
                for (int e = 0; e < 4; ++e) o4[e] = acc[4 * g + e] + ((n0 + e == mrow) ? gcv : 0.f);
                u32x2 w; w.x = cvtpk(o4[0], o4[1]); w.y = cvtpk(o4[2], o4[3]); *(u32x2*)(Gp + n0) = w; }
            acc = mm_tile<true, false>(lds + O_BCT, lds + O_Q1T, qn, qm, r32, hi, zero16());
            acc = mm_tile<true, true>(lds + O_KCT, lds + O_VT, qn, qm, r32, hi, acc);
            bf16_t* Hp = (bf16_t*)(uo + UO_HT) + mrow * 64;
#pragma unroll
            for (int g = 0; g < 4; ++g) { u32x2 w; w.x = cvtpk(acc[4 * g], acc[4 * g + 1]); w.y = cvtpk(acc[4 * g + 2], acc[4 * g + 3]); *(u32x2*)(Hp + 32 * qn + 8 * g + 4 * hi) = w; }
        } else {
            f32x16 acc = mm_tile(lds + O_P1T, lds + O_ARB, qn, qm, r32, hi, zero16());
            bf16_t* Yp = (bf16_t*)(uo + UO_Y1) + mrow * 64;
#pragma unroll
            for (int g = 0; g < 4; ++g) { const int n0 = 32 * qn + 8 * g + 4 * hi;
                const u32x2 rt = *(const LAS u32x2*)(lds + O_RT + mrow * STR + n0 * 2);
                u32x2 w; w.x = cvtpk(acc[4 * g] + bflo(rt.x), acc[4 * g + 1] + bfhi(rt.x)); w.y = cvtpk(acc[4 * g + 2] + bflo(rt.y), acc[4 * g + 3] + bfhi(rt.y)); *(u32x2*)(Yp + n0) = w; }
            acc = mm_tile(lds + O_Q1T, lds + O_ARB, qn, qm, r32, hi, zero16());
            acc = mm_tile<true, false>(lds + O_VT, lds + O_ARK, qn, qm, r32, hi, acc);
            bf16_t* Y0p = (bf16_t*)(uo + UO_Y0) + mrow * 64;
#pragma unroll
            for (int g = 0; g < 4; ++g) { u32x2 w; w.x = cvtpk(acc[4 * g], acc[4 * g + 1]); w.y = cvtpk(acc[4 * g + 2], acc[4 * g + 3]); *(u32x2*)(Y0p + 32 * qn + 8 * g + 4 * hi) = w; }
        }
    }
}

__device__ __forceinline__ void state_pass_job(const Args& A, int q, int lane) {
    const int r32 = lane & 31, hi = lane >> 5;
    int bh, half, nch, ubase; const float* init; float* fin;
    if (q < 128) { bh = q >> 1; half = q & 1; nch = 128; ubase = bh * 128; init = nullptr; fin = A.dout + OFF_SRP + (size_t)bh * 4096; }
    else { const int qs = q - 128; bh = qs >> 1; half = qs & 1; nch = 1; ubase = NPROMPT_UNITS + bh; init = A.state_in + (size_t)bh * 4096; fin = A.dout + OFF_SRS + (size_t)bh * 4096; }
    const int i = 32 * half + r32;
    f32x16 X[2];
#pragma unroll
    for (int t2 = 0; t2 < 2; ++t2)
#pragma unroll
        for (int g = 0; g < 4; ++g) {
            f32x4 v = (f32x4){0.f, 0.f, 0.f, 0.f};
            if (init) v = *(const f32x4*)(init + i * 64 + 32 * t2 + 8 * g + 4 * hi);
            X[t2][4 * g] = v[0]; X[t2][4 * g + 1] = v[1]; X[t2][4 * g + 2] = v[2]; X[t2][4 * g + 3] = v[3];
        }
    u32x4 gaA[2][2][2], gaB[2][2][2]; u32x2 htA[2][4], htB[2][4];
#define RW_FETCH(ga, ht, c_) do { \
        const unsigned char* uo_ = A.AOUT + (size_t)(ubase + (c_)) * UNIT_BYTES; \
        const bf16_t* Gp_ = (const bf16_t*)(uo_ + UO_G); const bf16_t* Hp_ = (const bf16_t*)(uo_ + UO_HT); \
        _Pragma("unroll") for (int jt = 0; jt < 2; ++jt) { \
            _Pragma("unroll") for (int t2 = 0; t2 < 2; ++t2) \
                _Pragma("unroll") for (int s = 0; s < 2; ++s) { const bf16_t* p_ = Gp_ + (32 * jt + r32) * 64 + 32 * t2 + 16 * s + 4 * hi; const u32x2 lo_ = *(const u32x2*)p_, hi_ = *(const u32x2*)(p_ + 8); ga[jt][t2][s] = (u32x4){lo_.x, lo_.y, hi_.x, hi_.y}; } \
            _Pragma("unroll") for (int g = 0; g < 4; ++g) ht[jt][g] = *(const u32x2*)(Hp_ + i * 64 + 32 * jt + 8 * g + 4 * hi); \
        } } while (0)
#define RW_STEP(ga, ht, c_, NEXT_) do { \
        bf16_t* Sp = A.S0 + (size_t)(ubase + (c_)) * 4096 + i * 64; \
        bf16x8 xb[2][2]; \
        _Pragma("unroll") for (int t2 = 0; t2 < 2; ++t2) { \
            _Pragma("unroll") for (int g = 0; g < 4; ++g) { u32x2 w; w.x = cvtpk(X[t2][4 * g], X[t2][4 * g + 1]); w.y = cvtpk(X[t2][4 * g + 2], X[t2][4 * g + 3]); *(u32x2*)(Sp + 32 * t2 + 8 * g + 4 * hi) = w; } \
            _Pragma("unroll") for (int s = 0; s < 2; ++s) { u32x4 w; w.x = cvtpk(X[t2][8 * s], X[t2][8 * s + 1]); w.y = cvtpk(X[t2][8 * s + 2], X[t2][8 * s + 3]); w.z = cvtpk(X[t2][8 * s + 4], X[t2][8 * s + 5]); w.w = cvtpk(X[t2][8 * s + 6], X[t2][8 * s + 7]); xb[t2][s] = __builtin_bit_cast(bf16x8, w); } \
        } \
        f32x16 acc[2]; \
        _Pragma("unroll") for (int jt = 0; jt < 2; ++jt) { \
            _Pragma("unroll") for (int g = 0; g < 4; ++g) { acc[jt][4 * g] = bflo(ht[jt][g].x); acc[jt][4 * g + 1] = bfhi(ht[jt][g].x); acc[jt][4 * g + 2] = bflo(ht[jt][g].y); acc[jt][4 * g + 3] = bfhi(ht[jt][g].y); } \
        } \
        _Pragma("unroll") for (int t2 = 0; t2 < 2; ++t2) \
            _Pragma("unroll") for (int s = 0; s < 2; ++s) \
                _Pragma("unroll") for (int jt = 0; jt < 2; ++jt) acc[jt] = __builtin_amdgcn_mfma_f32_32x32x16_bf16(__builtin_bit_cast(bf16x8, ga[jt][t2][s]), xb[t2][s], acc[jt], 0, 0, 0); \
        NEXT_; \
        X[0] = acc[0]; X[1] = acc[1]; } while (0)
    if (q < 128) {
        RW_FETCH(gaA, htA, 0); RW_FETCH(gaB, htB, 1);
#pragma unroll 1
        for (int c = 0; c < 128; c += 2) {
            RW_STEP(gaA, htA, c, RW_FETCH(gaA, htA, min(c + 2, 127)));
            RW_STEP(gaB, htB, c + 1, RW_FETCH(gaB, htB, min(c + 3, 127)));
        }
    } else {
        RW_FETCH(gaA, htA, 0);
        RW_STEP(gaA, htA, 0, (void)0);
    }
#undef RW_FETCH
#undef RW_STEP
#pragma unroll
    for (int t2 = 0; t2 < 2; ++t2)
#pragma unroll
        for (int g = 0; g < 4; ++g) *(f32x4*)(fin + i * 64 + 32 * t2 + 8 * g + 4 * hi) = (f32x4){X[t2][4 * g], X[t2][4 * g + 1], X[t2][4 * g + 2], X[t2][4 * g + 3]};
}

struct ScIn { u32x4 y1a, y1b, s0a, s0b, uva, uvb, upa, upb, gga, ggb; u32x2 y0v[4]; float rk; };
__device__ __forceinline__ void sc_load(const Args& A, int u0, ScIn& in) {
    const int tid = threadIdx.x, lane = tid & 63, wid = __builtin_amdgcn_readfirstlane(tid >> 6), r32 = lane & 31, hi = lane >> 5;
    const int uu = tid >> 8, x = tid & 255, u = unit_of(u0 + uu);
    const unsigned char* uo = A.AOUT + (size_t)u * UNIT_BYTES;
    int b, h, row0; bool sample, firstchunk; unit_decode(u, b, h, row0, sample, firstchunk);
    const int irow = x >> 2, seg = x & 3;
    const bf16_t* y1 = (const bf16_t*)(uo + UO_Y1) + irow * 64 + seg * 16; const bf16_t* s0 = A.S0 + (size_t)u * 4096 + irow * 64 + seg * 16;
    in.y1a = *(const u32x4*)y1; in.y1b = *(const u32x4*)(y1 + 8); in.s0a = *(const u32x4*)s0; in.s0b = *(const u32x4*)(s0 + 8);
    const int q = wid & 3, qn = q >> 1, qm = q & 1, tt = 32 * qm + r32;
    const bf16_t* Y0p = (const bf16_t*)(uo + UO_Y0) + tt * 64;
#pragma unroll
    for (int g = 0; g < 4; ++g) in.y0v[g] = *(const u32x2*)(Y0p + 32 * qn + 8 * g + 4 * hi);
    const int t = x >> 2, ig = x & 3, row = row0 + t, col = h * 64 + 16 * ig;
    in.uva = *(const u32x4*)(A.U + (size_t)row * 3584 + 2048 + col); in.uvb = *(const u32x4*)(A.U + (size_t)row * 3584 + 2048 + col + 8);
    in.upa = prev_row8(A, row, 2048 + col); in.upb = prev_row8(A, row, 2048 + col + 8);
    in.gga = *(const u32x4*)(A.GG + (size_t)row * 1024 + col); in.ggb = *(const u32x4*)(A.GG + (size_t)row * 1024 + col + 8);
    in.rk = A.RK[(size_t)row * 16 + h];
}
__device__ __forceinline__ void stage_c(LAS unsigned char* lds, const Args& A, int u0, const ScIn& in) {
    const int tid = threadIdx.x, lane = tid & 63, wid = __builtin_amdgcn_readfirstlane(tid >> 6), r32 = lane & 31, hi = lane >> 5;
    constexpr int UB = 2 * MAT + 64 * FSTR * 4;
    const int uu = tid >> 8, x = tid & 255, u = unit_of(u0 + uu);
    LAS unsigned char* base = lds + uu * UB;
    int b, h, row0; bool sample, firstchunk; unit_decode(u, b, h, row0, sample, firstchunk);
    const int irow = x >> 2, seg = x & 3;
    const int q = wid & 3, qn = q >> 1, qm = q & 1, tt = 32 * qm + r32;
    const int t = x >> 2, ig = x & 3, i0 = 16 * ig, row = row0 + t, col = h * 64 + i0;
    const bool first = firstchunk && t == 0;
    *(LAS u32x4*)(base + irow * STR + seg * 32) = in.y1a; *(LAS u32x4*)(base + irow * STR + seg * 32 + 16) = in.y1b;
    *(LAS u32x4*)(base + MAT + irow * STR + seg * 32) = in.s0a; *(LAS u32x4*)(base + MAT + irow * STR + seg * 32 + 16) = in.s0b;
    WG_BAR();
    LAS float* Yf = (LAS float*)(base + 2 * MAT);
    {
        f32x16 acc;
#pragma unroll
        for (int g = 0; g < 4; ++g) { acc[4 * g] = bflo(in.y0v[g].x); acc[4 * g + 1] = bfhi(in.y0v[g].x); acc[4 * g + 2] = bflo(in.y0v[g].y); acc[4 * g + 3] = bfhi(in.y0v[g].y); }
        acc = mm_tile(base + MAT, base, qn, qm, r32, hi, acc);
#pragma unroll
        for (int g = 0; g < 4; ++g) *(LAS f32x4*)(Yf + tt * FSTR + 32 * qn + 8 * g + 4 * hi) = (f32x4){acc[4 * g], acc[4 * g + 1], acc[4 * g + 2], acc[4 * g + 3]};
    }
    WG_BAR();
    {
        float y[16]; float s = 0.f;
#pragma unroll
        for (int e4 = 0; e4 < 4; ++e4) { const f32x4 v = *(const LAS f32x4*)(Yf + t * FSTR + i0 + 4 * e4); y[4 * e4] = v[0]; y[4 * e4 + 1] = v[1]; y[4 * e4 + 2] = v[2]; y[4 * e4 + 3] = v[3]; s += (v[0] + v[1]) + (v[2] + v[3]); }
        s += __shfl_xor(s, 1); s += __shfl_xor(s, 2);
        const float mean = s * (1.0f / 64.0f); float q2 = 0.f;
#pragma unroll
        for (int e = 0; e < 16; ++e) { y[e] -= mean; q2 += y[e] * y[e]; }
        q2 += __shfl_xor(q2, 1); q2 += __shfl_xor(q2, 2);
        const float rstd = rsqrtf(q2 * (1.0f / 64.0f) + 64e-5f);
        float v[16], gg[16], lg[16], lb[16], mm_[16];
        ld8(A.lnx_g + col, lg); ld8(A.lnx_g + col + 8, lg + 8); ld8(A.lnx_b + col, lb); ld8(A.lnx_b + col + 8, lb + 8); ld8(A.mu + 2048 + col, mm_); ld8(A.mu + 2048 + col + 8, mm_ + 8);
        { float uu_[16], pp_[16]; unpk8(in.uva, uu_); unpk8(in.uvb, uu_ + 8); unpk8(fix_first8(A, in.upa, 2048 + col, first, sample, b), pp_); unpk8(fix_first8(A, in.upb, 2048 + col + 8, first, sample, b), pp_ + 8);
#pragma unroll
          for (int e = 0; e < 16; ++e) v[e] = uu_[e] + mm_[e] * (pp_[e] - uu_[e]); }
        unpk8(in.gga, gg); unpk8(in.ggb, gg + 8);
        float o[16];
#pragma unroll
        for (int e = 0; e < 16; ++e) o[e] = (y[e] * rstd * lg[e] + lb[e] + in.rk * v[e]) * gg[e];
        *(u32x4*)(A.OB + (size_t)row * 1024 + col) = pk8(o); *(u32x4*)(A.OB + (size_t)row * 1024 + col + 8) = pk8(o + 8);
    }
    WG_BAR();
}
}
constexpr size_t MiB = 1u << 20;
constexpr size_t WS_CTL = 0, CTL_ZERO_BYTES = 1 * MiB;
constexpr int CW_BAR = 4096, CW_QUEUE = 8192;
constexpr size_t CTL_SS1 = 131072, CTL_SS2 = CTL_SS1 + 139264, CTL_SS3 = CTL_SS2 + 139264, CTL_SS4 = CTL_SS3 + 139264;
constexpr size_t WS_W1I = 2 * MiB, WS_W1O = 46 * MiB, WS_WIN = 68 * MiB, WS_WLO = 110 * MiB, WS_WPA = 113 * MiB, WS_WPB = 117 * MiB, WS_WOU = 121 * MiB, WS_W2I = 129 * MiB, WS_W2O = 173 * MiB;
constexpr size_t WS_XB = 196 * MiB;
constexpr size_t WS_OA = WS_XB, WS_OB = WS_XB + 68 * MiB;
constexpr size_t WS_QB = 332 * MiB, WS_KB = 400 * MiB, WS_VB = 464 * MiB;
constexpr size_t WS_MG = 332 * MiB;
constexpr size_t WS_RA = 528 * MiB;
constexpr size_t WS_GA = 936 * MiB, WS_GB = 1072 * MiB;
constexpr size_t WS_U = 1208 * MiB;
constexpr size_t WS_LIN = 828 * MiB;
constexpr size_t WS_LW = 1480 * MiB, WS_AS = 1616 * MiB, WS_GG = 1752 * MiB;
constexpr size_t WS_S0 = 1820 * MiB, WS_RK = 1888 * MiB, WS_XR = 1892 * MiB, WS_END = 2028 * MiB;
constexpr int NWIN = 10752, NLORA = 3072, KLORA = 256, LDLIN = 768;
constexpr int LDS_BYTES = 147456, RING_BYTES = 131072, MISC_OFF = LDS_BYTES - 512;
constexpr int NWAVES = 8;

#define XB_TMO      128
#define XB_XCNT(j)  (256  + 64 * (j))
#define XB_XSUB(j)  (1280 + 64 * (j))
#define XB_XGEN(j)  (2304 + 64 * (j))
#define XB_TOP      3328
#define XB_TOPGEN   3392
#define XCD_BAR_WORDS 3456
#define XB_SPIN_CAP (1u << 18)

__device__ __forceinline__ unsigned xb_ld(unsigned* p)              { return __hip_atomic_load(p, __ATOMIC_RELAXED, __HIP_MEMORY_SCOPE_AGENT); }
__device__ __forceinline__ unsigned xb_add(unsigned* p, unsigned v) { return __hip_atomic_fetch_add(p, v, __ATOMIC_RELAXED, __HIP_MEMORY_SCOPE_AGENT); }
__device__ __forceinline__ unsigned xb_xcc_id() { return (unsigned)__builtin_amdgcn_s_getreg((3 << 11) | 20) & 0xFu; }
#define XB_SPIN(cond, bar) do { unsigned _sp = 0; while (cond) { __builtin_amdgcn_s_sleep(1); \
    if ((++_sp & 255u) == 0u) { if (xb_ld(&(bar)[XB_TMO])) break; if (_sp > XB_SPIN_CAP) { atomicAdd(&(bar)[XB_TMO], 1u); break; } } } } while (0)

struct XcdBarrier {
    unsigned* bar; unsigned x;
    volatile LAS unsigned* st;
};

__device__ __forceinline__ XcdBarrier xcd_barrier_post(unsigned* bar, volatile LAS unsigned* st) {
    XcdBarrier b; b.bar = bar; b.x = xb_xcc_id(); b.st = st;
    if (threadIdx.x == 0) (void)xb_add(&bar[XB_XCNT(b.x)], 1u);
    return b;
}
__device__ __forceinline__ void xcd_barrier_complete(unsigned* bar, unsigned x, unsigned& nloc, unsigned& nx) {
    const unsigned G = gridDim.x * gridDim.y * gridDim.z;
    unsigned sum, cnt, mine, sp = 0u;
    for (;;) {
        sum = 0u; cnt = 0u; mine = 0u;
#pragma unroll
        for (unsigned j = 0; j < 16; ++j) { const unsigned c = xb_ld(&bar[XB_XCNT(j)]); sum += c; cnt += (c > 0u) ? 1u : 0u; mine = (j == x) ? c : mine; }
        if (sum == G) break;
        __builtin_amdgcn_s_sleep(1);
        if ((++sp & 255u) == 0u) { if (xb_ld(&bar[XB_TMO])) break; if (sp > XB_SPIN_CAP) { atomicAdd(&bar[XB_TMO], 1u); break; } }
    }
    nloc = mine > 0u ? mine : 1u; nx = cnt > 0u ? cnt : 1u;
}

__device__ __forceinline__ void xcd_barrier(const XcdBarrier& b) {
    asm volatile("s_waitcnt vmcnt(0)" ::: "memory");
    __syncthreads();
    if (threadIdx.x == 0) {
        unsigned* bar = b.bar;
        __builtin_amdgcn_s_waitcnt(0);
        unsigned nloc = b.st[0], nx = b.st[1];
        if (nloc == 0u) { xcd_barrier_complete(bar, b.x, nloc, nx); b.st[0] = nloc; b.st[1] = nx; }
        const unsigned old = xb_add(&bar[XB_XSUB(b.x)], 1u);
        const unsigned gen = old / nloc;
        if (old + 1u == (gen + 1u) * nloc) {
            __builtin_amdgcn_fence(__ATOMIC_RELEASE, "agent");
            asm volatile("s_waitcnt vmcnt(0)" ::: "memory");
            const unsigned og = xb_add(&bar[XB_TOP], 1u);
            const unsigned tg = og / nx;
            if (og + 1u == (tg + 1u) * nx) xb_add(&bar[XB_TOPGEN], 1u);
            else XB_SPIN(xb_ld(&bar[XB_TOPGEN]) == tg, bar);
            __builtin_amdgcn_fence(__ATOMIC_ACQUIRE, "agent");
            xb_add(&bar[XB_XGEN(b.x)], 1u);
            asm volatile("s_waitcnt vmcnt(0)" ::: "memory");
        } else {
            XB_SPIN(xb_ld(&bar[XB_XGEN(b.x)]) == gen, bar);
            __builtin_amdgcn_fence(__ATOMIC_ACQUIRE, "agent");
            asm volatile("s_waitcnt vmcnt(0)" ::: "memory");
        }
    }
    __syncthreads();
}

struct KArgs { const float* in[34]; float* out; unsigned char* ws; int ph_lo, ph_hi; };
constexpr int NPHASE = 15;

__device__ __forceinline__ float wave_sum(float v) {
#pragma unroll
    for (int o = 1; o < 64; o <<= 1) v += __shfl_xor(v, o);
    return v;
}
template <bool GAIN> __device__ __forceinline__ void transpose_item(const float* W, int K, int N, bf16_t* WT, const float* gain, int k0, int n0, int dst_row0, LAS unsigned char* scr, int lane) {
    asm volatile("" : "+v"(lane));
    const int c4 = lane & 15, kr = lane >> 4;
#pragma unroll
    for (int h8 = 0; h8 < 2; ++h8) {
        f32x4 v[8]; float g[8];
#pragma unroll
        for (int i = 0; i < 8; ++i) { const int k = 4 * (8 * h8 + i) + kr; v[i] = *(const f32x4*)(W + (size_t)(k0 + k) * N + n0 + 4 * c4); if (GAIN) g[i] = gain[k0 + k]; }
#pragma unroll
        for (int i = 0; i < 8; ++i) { const int k = 4 * (8 * h8 + i) + kr; f32x4 x = v[i]; if (GAIN) x = x * g[i]; u32x2 w; w.x = cvtpk(x[0], x[1]); w.y = cvtpk(x[2], x[3]); *(LAS u32x2*)(scr + k * 144 + c4 * 8) = w; }
    }
    asm volatile("s_waitcnt lgkmcnt(0)" ::: "memory");
    const int gq = lane >> 4, i16 = lane & 15;
#pragma unroll
    for (int j = 0; j < 8; ++j) {
        const int kc = 4 * (j & 1) + gq, nb = j >> 1;
        const LAS unsigned char* p = scr + (8 * kc + (i16 >> 2)) * 144 + (16 * nb + 4 * (i16 & 3)) * 2;
        const s16x4 lo = vtr(p), hi = vtr(p + 4 * 144);
        u32x4 o; o.x = (unsigned)(unsigned short)lo[0] | ((unsigned)(unsigned short)lo[1] << 16); o.y = (unsigned)(unsigned short)lo[2] | ((unsigned)(unsigned short)lo[3] << 16);
        o.z = (unsigned)(unsigned short)hi[0] | ((unsigned)(unsigned short)hi[1] << 16); o.w = (unsigned)(unsigned short)hi[2] | ((unsigned)(unsigned short)hi[3] << 16);
        *(u32x4*)(WT + (size_t)(dst_row0 + 16 * nb + i16) * K + k0 + 8 * kc) = o;
    }
    asm volatile("s_waitcnt lgkmcnt(0)" ::: "memory");
}
template <bool GAIN> __device__ __forceinline__ void transpose_matrix(const float* W, int K, int N, bf16_t* WT, const float* gain, int map, LAS unsigned char* scr, int gw, int ngw, int lane) {
    const int nblk = N / 64, nitems = (K / 64) * nblk;
    for (int it = gw; it < nitems; it += ngw) {
        const int kb = it / nblk, nb = it % nblk, n0 = 64 * nb;
        int d0 = n0;
        if (map == 1) d0 = (n0 < FFD) ? 256 * (n0 / 128) + (n0 % 128) : 256 * ((n0 - FFD) / 128) + 128 + ((n0 - FFD) % 128);
        else if (map == 2) d0 = (n0 < 6592) ? n0 : n0 + 64;
        transpose_item<GAIN>(W, K, N, WT, gain, 64 * kb, n0, d0, scr, lane);
    }
}

__global__ void __launch_bounds__(NWAVES * 64, 2) fwd_kernel(KArgs args) {
    extern __shared__ __attribute__((aligned(16))) unsigned char lds_raw[];
    LAS unsigned char* lds = (LAS unsigned char*)lds_raw;
    volatile LAS unsigned* MISC = (volatile LAS unsigned*)(lds + MISC_OFF);
    const int tid = threadIdx.x, lane = tid & 63, wave = __builtin_amdgcn_readfirstlane(tid >> 6);
    const int G = gridDim.x; const int bx = blockIdx.x; const int vcu = (G % 8 == 0) ? (bx % 8) * (G / 8) + bx / 8 : bx;
    unsigned char* ws = args.ws; float* dout = args.out;
    unsigned* ctl = (unsigned*)(ws + WS_CTL);
    for (int u = tid; u < (LDS_BYTES - RING_BYTES) / 4; u += NWAVES * 64) ((LAS unsigned*)(lds + RING_BYTES))[u] = 0u;
    __syncthreads();
    const int lo = args.ph_lo, hi_ = args.ph_hi;
    const bool use_bar = (hi_ - lo) > 1;
    XcdBarrier bar; bar.bar = ctl + CW_BAR; bar.x = 0; bar.st = nullptr;
    if (use_bar) bar = xcd_barrier_post(ctl + CW_BAR, MISC + 8);
#ifndef ONLY_PHASE
#define ONLY_PHASE -1
#endif
#define IN(k) ((ONLY_PHASE < 0 || ONLY_PHASE == (k)) && lo <= (k) && (k) < hi_)
#define SEAM(k) do { if (IN(k) && IN((k) + 1)) xcd_barrier(bar); } while (0)

    const float* x_prompt = args.in[0]; const float* x_sample = args.in[1];
    float* ss1 = (float*)(ws + CTL_SS1); float* ss2 = (float*)(ws + CTL_SS2); float* ss3 = (float*)(ws + CTL_SS3); float* ss4 = (float*)(ws + CTL_SS4);
    bf16_t* W1I = (bf16_t*)(ws + WS_W1I); bf16_t* W1O = (bf16_t*)(ws + WS_W1O); bf16_t* WIN = (bf16_t*)(ws + WS_WIN); bf16_t* WLO = (bf16_t*)(ws + WS_WLO);
    bf16_t* WPA = (bf16_t*)(ws + WS_WPA); bf16_t* WPB = (bf16_t*)(ws + WS_WPB); bf16_t* WOU = (bf16_t*)(ws + WS_WOU); bf16_t* W2I = (bf16_t*)(ws + WS_W2I); bf16_t* W2O = (bf16_t*)(ws + WS_W2O);
    bf16_t* XR = (bf16_t*)(ws + WS_XR); bf16_t* XB = (bf16_t*)(ws + WS_XB); bf16_t* OA = (bf16_t*)(ws + WS_OA); bf16_t* OB = (bf16_t*)(ws + WS_OB);
    bf16_t* QB = (bf16_t*)(ws + WS_QB); bf16_t* KB = (bf16_t*)(ws + WS_KB); bf16_t* VB = (bf16_t*)(ws + WS_VB); bf16_t* MG = (bf16_t*)(ws + WS_MG);
    bf16_t* ACT = (bf16_t*)(ws + WS_RA); bf16_t* GA = (bf16_t*)(ws + WS_GA); bf16_t* GB = (bf16_t*)(ws + WS_GB); bf16_t* U = (bf16_t*)(ws + WS_U); bf16_t* LIN = (bf16_t*)(ws + WS_LIN);
    bf16_t* LW = (bf16_t*)(ws + WS_LW); bf16_t* AS = (bf16_t*)(ws + WS_AS); bf16_t* GG = (bf16_t*)(ws + WS_GG);
    float* X = dout + OFF_YP;

    if (IN(0)) {
        LAS unsigned char* scr = lds + wave * 16384;
        const int gw = vcu * NWAVES + wave, ngw = G * NWAVES;
        transpose_matrix<true>(args.in[7], DM, 2 * FFD, W1I, args.in[6], 1, scr, gw, ngw, lane);
        const int gt = vcu * NWAVES * 64 + tid, ngt = G * NWAVES * 64;
        for (int i = gt; i < 64 * 2048 / 8; i += ngt) *(u32x4*)(WIN + (size_t)6592 * 2048 + (size_t)i * 8) = (u32x4){0u, 0u, 0u, 0u};
        {
            const float* w2 = args.in[18]; const float* a2 = args.in[20]; const float* g2 = args.in[21];
            for (int it = gt; it < NLORA * (KLORA / 8); it += ngt) {
                const int n = it % NLORA, k0 = (it / NLORA) * 8; float o[8];
#pragma unroll
                for (int e = 0; e < 8; ++e) { const int k = k0 + e; float v = 0.f;
                    if (n < 1024) { if (k < 96) v = w2[(size_t)k * 1024 + n]; }
                    else if (n < 2048) { if (k < 96) v = a2[(size_t)k * 1024 + (n - 1024)]; }
                    else v = g2[(size_t)k * 1024 + (n - 2048)];
                    o[e] = v; }
                *(u32x4*)(WLO + (size_t)n * KLORA + k0) = pk8(o);
            }
        }
        for (int m = gw; m < MROWS; m += 2 * ngw) {
            const int m2 = m + ngw; const bool has2 = m2 < MROWS; const int mb = has2 ? m2 : m;
            const float* xa = (m < MP) ? x_prompt + (size_t)m * DM : x_sample + (size_t)(m - MP) * DM;
            const float* xc = (mb < MP) ? x_prompt + (size_t)mb * DM : x_sample + (size_t)(mb - MP) * DM;
            f32x4 va[8], vb[8];
#pragma unroll
            for (int j = 0; j < 8; ++j) { va[j] = *(const f32x4*)(xa + 4 * lane + 256 * j); vb[j] = *(const f32x4*)(xc + 4 * lane + 256 * j); }
            float sa = 0.f, sb = 0.f;
#pragma unroll
            for (int j = 0; j < 8; ++j) { const f32x4 v = va[j]; sa += (v[0] * v[0] + v[1] * v[1]) + (v[2] * v[2] + v[3] * v[3]);
                u32x2 w; w.x = cvtpk(v[0], v[1]); w.y = cvtpk(v[2], v[3]); *(u32x2*)(XB + (size_t)m * DM + 4 * lane + 256 * j) = w; }
            sa = wave_sum(sa);
            if (lane == 0) ss1[m] = sa;
            if (has2) {
#pragma unroll
                for (int j = 0; j < 8; ++j) { const f32x4 v = vb[j]; sb += (v[0] * v[0] + v[1] * v[1]) + (v[2] * v[2] + v[3] * v[3]);
                    u32x2 w; w.x = cvtpk(v[0], v[1]); w.y = cvtpk(v[2], v[3]); *(u32x2*)(XB + (size_t)m2 * DM + 4 * lane + 256 * j) = w; }
                sb = wave_sum(sb);
                if (lane == 0) ss1[m2] = sb;
            }
        }
    }
    SEAM(0);
#define FILLER(nunits_, ...) do { const int nlong_ = (nunits_) % G; if (nlong_ != 0 && bx >= nlong_) { const int fgw = (bx - nlong_) * NWAVES + wave, fngw = (G - nlong_) * NWAVES; LAS unsigned char* fscr = lds + wave * 16384; __VA_ARGS__ __syncthreads(); } } while (0)
    if (IN(1)) FILLER((MROWS / 256) * (2 * FFD / 256), transpose_matrix<false>(args.in[8], FFD, DM, W1O, nullptr, 0, fscr, fgw, fngw, lane););
    if (IN(1)) { pg8::Gemm g{XB, W1I, MROWS, 2 * FFD, DM}; pg8::StaticOrder S; S.init(MROWS, 2 * FFD, G, bx); pg8::EpiSwiGLU E{ACT, ss1};
        pg8::gemm_phase<pg8::EpiSwiGLU, pg8::StaticOrder, true, true>(lds, g, S, E); }
    SEAM(1);
    if (IN(2)) { LAS unsigned char* fscr = lds + wave * 16384; transpose_matrix<true>(args.in[10], DM, 10688, WIN, args.in[9], 2, fscr, vcu * NWAVES + wave, G * NWAVES, lane); __syncthreads(); }
    if (IN(2)) { pg8::Gemm g{ACT, W1O, MROWS, DM, FFD}; pg8::PanelOrder S{bx, 0}; pg8::EpiResid<true, true> E{nullptr, nullptr, XB, nullptr, XR, ss2, 0.5f};
        pg8::gemm_phase<pg8::EpiResid<true, true>, pg8::PanelOrder, true, true>(lds, g, S, E); }
    if (IN(2)) xcd_barrier(bar);
    if (IN(2)) {
        if (bx < 64) { pg8::Gemm g{ACT, W1O, MROWS, DM, FFD}; pg8::PanelOrder S{bx, 1}; pg8::EpiResid<true, true> E{nullptr, nullptr, XB, nullptr, XR, ss2, 0.5f};
            pg8::gemm_phase<pg8::EpiResid<true, true>, pg8::PanelOrder, true, true>(lds, g, S, E); }
        else { pg8::Gemm g{XR, WIN, MROWS, NWIN, DM}; pg8::RangeOrder S{MROWS / 256, NWIN / 256, (MROWS / 256) * (NWIN / 256) / 8, bx & 7, (bx - 64) >> 3, 24, 0, 72}; pg8::EpiWin E{ss2, QB, KB, VB, dout, U, GA, GB};
            pg8::gemm_phase<pg8::EpiWin, pg8::RangeOrder, true, true>(lds, g, S, E); }
    }
    SEAM(2);
    if (IN(3)) { pg8::Gemm g{XR, WIN, MROWS, NWIN, DM}; pg8::RangeOrder S{MROWS / 256, NWIN / 256, (MROWS / 256) * (NWIN / 256) / 8, bx & 7, bx >> 3, 32, 72, 642}; pg8::EpiWin E{ss2, QB, KB, VB, dout, U, GA, GB};
        pg8::gemm_phase<pg8::EpiWin, pg8::RangeOrder, true, true>(lds, g, S, E); }
    if (IN(3)) { if (bx >= 16) { const int fgw = (bx - 16) * NWAVES + wave, fngw = (G - 16) * NWAVES; LAS unsigned char* fscr = lds + wave * 16384;
        transpose_matrix<false>(args.in[27], 1024, DM, WPA, nullptr, 0, fscr, fgw, fngw, lane); transpose_matrix<false>(args.in[28], 1024, DM, WPB, nullptr, 0, fscr, fgw, fngw, lane); transpose_matrix<false>(args.in[29], DM, DM, WOU, nullptr, 0, fscr, fgw, fngw, lane); __syncthreads(); } }
    SEAM(3);
    rw::Args RA;
    RA.U = U; RA.LW = LW; RA.AS = AS; RA.GG = GG; RA.mu = args.in[16]; RA.shift_in = args.in[5]; RA.state_in = args.in[4];
    RA.k_k = args.in[22]; RA.k_a = args.in[23]; RA.r_k = args.in[24]; RA.lnx_g = args.in[25]; RA.lnx_b = args.in[26];
    RA.AOUT = ws + WS_RA; RA.S0 = (bf16_t*)(ws + WS_S0); RA.RK = (float*)(ws + WS_RK); RA.OB = OB; RA.dout = dout;
    if (IN(4)) {
        for (int blk = vcu; blk < MROWS / 16; blk += G) {
            const int row = blk * 16 + (tid >> 5);
            const bool sample = row >= MP; const int t = sample ? ((row - MP) & 63) : (row & 8191), b = sample ? ((row - MP) >> 6) : (row >> 13);
#pragma unroll
            for (int k3 = 0; k3 < 3; ++k3) {
                const int cg = (tid & 31) + 32 * k3;
                float o[8];
                const int src = (cg < 12) ? cg : (cg >= 32 && cg < 44) ? cg - 20 : (cg >= 64) ? cg - 40 : -1;
                if (src >= 0) {
                    rw::shifted8(RA, row, 3072 + 8 * src, t == 0, sample, b, o);
#pragma unroll
                    for (int e = 0; e < 8; ++e) { if (cg < 12) { const float ex = __expf(2.0f * o[e]); o[e] = 1.0f - 2.0f * __builtin_amdgcn_rcpf(ex + 1.0f); } else if (cg >= 64) o[e] = pg8::sigm(o[e]); }
                } else {
#pragma unroll
                    for (int e = 0; e < 8; ++e) o[e] = 0.f; }
                *(u32x4*)(LIN + (size_t)(cg >> 5) * ((size_t)MROWS * 256) + (size_t)row * 256 + 8 * (cg & 31)) = pk8(o);
            }
        }
    }
    SEAM(4);
    if (IN(5)) { pg8::Gemm g{LIN, WLO, MROWS, NLORA, KLORA}; pg8::LoraOrder S; S.so.init(MROWS, NLORA, G, bx); pg8::EpiLora E{args.in[17], args.in[19], LW, AS, GG};
        pg8::gemm_phase<pg8::EpiLora, pg8::LoraOrder, true, true>(lds, g, S, E); }
    SEAM(5);
    if (IN(6)) {
        {
            LAS float* ptab = (LAS float*)(lds + rw::PT_OFF);
            for (int i = tid; i < 16 * 6 * 16; i += NWAVES * 64) { const int hh = i / 96, r = i % 96, arr = r >> 4, j4 = (r & 15) * 4;
                const float* src = (arr == 0 ? RA.k_k : arr == 1 ? RA.k_a : arr == 2 ? RA.r_k : RA.mu + (arr - 3) * 1024) + hh * 64 + j4;
                *(LAS f32x4*)(ptab + hh * 384 + arr * 64 + j4) = *(const f32x4*)src; }
            __syncthreads(); }
        rw::PrepIn pin; if (vcu < rw::NUNITS) rw::prep_load(RA, rw::unit_of(vcu), pin); for (int w = vcu; w < rw::NUNITS; w += G) rw::stage_a(lds, RA, rw::unit_of(w), pin, (w + G < rw::NUNITS) ? rw::unit_of(w + G) : -1); }
    SEAM(6);
    if (IN(7)) {
        float lam;
        { const float a = wave_sum(args.in[11][lane] * args.in[12][lane]), b2 = wave_sum(args.in[13][lane] * args.in[14][lane]); lam = __expf(a) - __expf(b2) + 0.2f; }
        unsigned* qhead = ctl + CW_QUEUE;
        for (;;) {
            if (tid == 0) MISC[16] = __hip_atomic_fetch_add(qhead, 1u, __ATOMIC_RELAXED, __HIP_MEMORY_SCOPE_AGENT);
            __syncthreads();
            const int it = (int)MISC[16];
            __syncthreads();
            if (it >= 2448) break;
            if (it < 16) { rw::state_pass_job(RA, it * 8 + wave, lane); }
            else if (it < 144) { rw::state_pass_job(RA, 128 + (it - 16) * 8 + wave, lane); }
            else if (it < 2192) {
                const int j = it - 144, qb = 63 - (j >> 5), bh = j & 31, b = bh >> 3, h = bh & 7;
                att::Src S; S.k = KB + (size_t)b * 8192 * 1024 + h * 128; S.v = VB + (size_t)b * 8192 * 1024 + h * 128; S.kn = nullptr; S.vn = nullptr;
                const size_t r0 = (size_t)b * 8192 + (size_t)qb * 128;
                att::unit<false>(lds, QB + r0 * 1024 + h * 128, S, 2 * qb + 1, 2 * qb + 2, OA + r0 * 1024 + h * 128, lam, args.in[15]);
            } else {
                const int j = it - 2192, b = j >> 3, h = j & 7;
                att::Src S; S.k = args.in[2] + (size_t)b * 4096 * 1024 + h * 128; S.v = args.in[3] + (size_t)b * 4096 * 1024 + h * 128;
                S.kn = dout + OFF_KS + (size_t)b * 64 * 1024 + h * 128; S.vn = dout + OFF_VS + (size_t)b * 64 * 1024 + h * 128;
                att::unit<true>(lds, QB + (size_t)(MP + b * 64) * 1024 + h * 128, S, 65, 0, OA + (size_t)(MP + b * 64) * 1024 + h * 128, lam, args.in[15]);
            }
        }
    }
    SEAM(7);
    if (IN(8)) { rw::ScIn sa, sb; constexpr int NPAIR = rw::NUNITS / 2; if (vcu < NPAIR) rw::sc_load(RA, 2 * vcu, sa);
#pragma unroll 1
        for (int p = vcu; p < NPAIR; p += 2 * G) {
            if (p + G < NPAIR) rw::sc_load(RA, 2 * (p + G), sb);
            rw::stage_c(lds, RA, 2 * p, sa);
            if (p + G < NPAIR) { if (p + 2 * G < NPAIR) rw::sc_load(RA, 2 * (p + 2 * G), sa); rw::stage_c(lds, RA, 2 * (p + G), sb); } } }
    SEAM(8);
    if (IN(10)) FILLER((MROWS / 256) * (DM / 256), transpose_matrix<false>(args.in[32], FFD, DM, W2O, nullptr, 0, fscr, fgw, fngw, lane););
    if (IN(10)) {
        { pg8::Gemm g{OA, WPA, MROWS, DM, 1024}; pg8::StaticOrder S; S.init(MROWS, DM, G, bx); pg8::EpiProj<false> E{GA, MG}; pg8::gemm_phase<pg8::EpiProj<false>, pg8::StaticOrder, true, true>(lds, g, S, E); }
        __syncthreads();
        { pg8::Gemm g{OB, WPB, MROWS, DM, 1024}; pg8::StaticOrder S; S.init(MROWS, DM, G, bx); pg8::EpiProj<true> E{GB, MG}; pg8::gemm_phase<pg8::EpiProj<true>, pg8::StaticOrder, true, true>(lds, g, S, E); }
    }
    SEAM(10);
    if (IN(11)) FILLER((MROWS / 256) * (DM / 256), transpose_matrix<true>(args.in[31], DM, 2 * FFD, W2I, args.in[30], 1, fscr, fgw, fngw, lane););
    if (IN(11)) { pg8::Gemm g{MG, WOU, MROWS, DM, DM}; pg8::StaticOrder S; S.init(MROWS, DM, G, bx); pg8::EpiResid<true, true> E{nullptr, nullptr, XR, nullptr, XB, ss3, 1.0f};
        pg8::gemm_phase<pg8::EpiResid<true, true>, pg8::StaticOrder, true, true>(lds, g, S, E); }
    SEAM(11);
    if (IN(12)) { pg8::Gemm g{XB, W2I, MROWS, 2 * FFD, DM}; pg8::StaticOrder S; S.init(MROWS, 2 * FFD, G, bx); pg8::EpiSwiGLU E{ACT, ss3};
        pg8::gemm_phase<pg8::EpiSwiGLU, pg8::StaticOrder, true, true>(lds, g, S, E); }
    SEAM(12);
    if (IN(13)) { pg8::Gemm g{ACT, W2O, MROWS, DM, FFD}; pg8::PanelOrder S{bx, 0}; pg8::EpiResid<true, true> E{nullptr, nullptr, XB, nullptr, XR, ss4, 0.5f};
        pg8::gemm_phase<pg8::EpiResid<true, true>, pg8::PanelOrder, true, true>(lds, g, S, E); }
    SEAM(13);
#define FINAL_NORM_ROW(m_) do { float* yr = X + (size_t)(m_) * DM; const bf16_t* xr = XR + (size_t)(m_) * DM; const float rs = rsqrtf(ss4[m_] * (1.0f / 2048.0f) + 1e-6f); \
        _Pragma("unroll") for (int j = 0; j < 4; ++j) { const u32x4 w = *(const u32x4*)(xr + 8 * lane + 512 * j); float v[8]; unpk8(w, v); \
            const f32x4 g0 = *(const f32x4*)(fg + 8 * lane + 512 * j), g1 = *(const f32x4*)(fg + 8 * lane + 512 * j + 4); \
            *(f32x4*)(yr + 8 * lane + 512 * j) = (f32x4){v[0] * rs * g0[0], v[1] * rs * g0[1], v[2] * rs * g0[2], v[3] * rs * g0[3]}; \
            *(f32x4*)(yr + 8 * lane + 512 * j + 4) = (f32x4){v[4] * rs * g1[0], v[5] * rs * g1[1], v[6] * rs * g1[2], v[7] * rs * g1[3]}; } } while (0)
    if (IN(14)) {
        const float* fg = args.in[33];
        if (bx < 64) { pg8::Gemm g{ACT, W2O, MROWS, DM, FFD}; pg8::PanelOrder S{bx, 1}; pg8::EpiResid<true, true> E{nullptr, nullptr, XB, nullptr, XR, ss4, 0.5f};
            pg8::gemm_phase<pg8::EpiResid<true, true>, pg8::PanelOrder, true, true>(lds, g, S, E); }
        else { for (int m = (bx - 64) * NWAVES + wave; m < MP; m += (G - 64) * NWAVES) FINAL_NORM_ROW(m); }
        xcd_barrier(bar);
        for (int m = MP + bx * NWAVES + wave; m < MROWS; m += G * NWAVES) FINAL_NORM_ROW(m);
    }
#undef FINAL_NORM_ROW
#undef IN
#undef SEAM
}

extern "C" void kernel_launch(void* const* d_in, const int* in_sizes, int n_in, void* d_out, int out_size, void* d_ws, size_t ws_size, hipStream_t stream) {
    static int grid = 0;
    if (grid == 0) {
        if (n_in != 34 || (size_t)out_size != OUT_TOTAL || ws_size < WS_END) { fprintf(stderr, "kernel_launch: unexpected shapes: n_in %d out %d ws %zu\n", n_in, out_size, ws_size); grid = -1; return; }
        int dev = 0, cus = 0;
        if (hipGetDevice(&dev) != hipSuccess || hipDeviceGetAttribute(&cus, hipDeviceAttributeMultiprocessorCount, dev) != hipSuccess) { grid = -1; return; }
        if (hipFuncSetAttribute((const void*)fwd_kernel, hipFuncAttributeMaxDynamicSharedMemorySize, LDS_BYTES) != hipSuccess) { fprintf(stderr, "kernel_launch: hipFuncSetAttribute failed\n"); grid = -1; return; }
        int per_cu = 0;
        if (hipOccupancyMaxActiveBlocksPerMultiprocessor(&per_cu, (const void*)fwd_kernel, NWAVES * 64, LDS_BYTES) != hipSuccess || per_cu < 1) fprintf(stderr, "kernel_launch: occupancy query says %d\n", per_cu);
        (void)hipGetLastError();
        grid = cus;
    }
    if (grid < 0) return;
    (void)hipMemsetAsync((char*)d_ws + WS_CTL, 0, CTL_ZERO_BYTES, stream);
    KArgs a{};
    for (int i = 0; i < 34; ++i) a.in[i] = (const float*)d_in[i];
    a.out = (float*)d_out; a.ws = (unsigned char*)d_ws;
#ifndef ONE_LAUNCH
#define ONE_LAUNCH 1
#endif
    if (ONE_LAUNCH) { a.ph_lo = 0; a.ph_hi = NPHASE; hipLaunchKernelGGL(fwd_kernel, dim3(grid), dim3(NWAVES * 64), LDS_BYTES, stream, a); }
#ifndef LAST_PHASE
#define LAST_PHASE (NPHASE - 1)
#endif
    else for (int p = 0; p <= LAST_PHASE; ++p) { a.ph_lo = p; a.ph_hi = p + 1; hipLaunchKernelGGL(fwd_kernel, dim3(grid), dim3(NWAVES * 64), LDS_BYTES, stream, a); }
}
```

```cpp
#include <hip/hip_runtime.h>
#include <hip/hip_bf16.h>
#include <cstdio>
#include <cstdint>
constexpr int MROWS = 34816, MP = 32768, DM = 2048, FFD = 5632;
constexpr size_t OFF_YP = 0, OFF_YS = 67108864, OFF_KP = 71303168, OFF_VP = 104857600, OFF_SRP = 138412032, OFF_SHP = 138674176,
                 OFF_KS = 138688256, OFF_VS = 140785408, OFF_SRS = 142882560, OFF_SHS = 144979712, OUT_TOTAL = 145092352;
constexpr float QSCALE = 0.125f * 1.4426950408889634f;
namespace pg8 {
#define PG8_LAS __attribute__((address_space(3)))
typedef unsigned short bf16_t;
typedef short bf16x8 __attribute__((ext_vector_type(8)));
typedef float f32x4 __attribute__((ext_vector_type(4)));
typedef unsigned u32x4 __attribute__((ext_vector_type(4)));
constexpr int BM = 256, BK = 64, HALF = 128, HTB = HALF * BK * 2  , STAGE_BYTES = 8 * HTB, NXCD = 8, WGM = 8;

__host__ __device__ __forceinline__ int lds_byte(int r, int c) { const int st = (r >> 4) * 2 + (c >> 5), rr = r & 15, cc = c & 31, ob = rr * 64 + cc * 2; return st * 1024 + (ob ^ (((ob >> 9) & 1) << 5)); }
__host__ __device__ __forceinline__ void stage_rc(int b, int& R, int& C) { const int st = b / 1024, sb = b % 1024, swz = sb ^ (((sb >> 9) & 1) << 5); R = (st >> 1) * 16 + swz / 64; C = (st & 1) * 32 + (swz % 64) / 2; }
__host__ __device__ __forceinline__ int perm32(int rho) { const int n = rho >> 4, i = rho & 15; return 8 * (i >> 2) + 4 * n + (i & 3); }

struct Unit { int pm, pn, oa; };
struct Gemm { const bf16_t* A; const bf16_t* Bt; int M, N, K, lda; };

struct StaticOrder {
    int nM, nN, nwg, G, c;
    __host__ __device__ void init(int M, int N, int G_, int c_) { nM = M / BM; nN = N / BM; nwg = nM * nN; G = G_; c = c_; }
    __host__ __device__ bool next(int i, Unit& u) const {
        const long L = (long)i * G + c; if (L >= nwg) return false;
        int wgid = (int)L; { const int q = nwg / NXCD, r = nwg % NXCD, xcd = wgid % NXCD, off = wgid / NXCD; wgid = (xcd < r ? xcd * (q + 1) : r * (q + 1) + (xcd - r) * q) + off; }
        const int nig = WGM * nN, gid = wgid / nig, fm = gid * WGM, gsz = (nM - fm) < WGM ? (nM - fm) : WGM;
        u.pm = fm + ((wgid % nig) % gsz); u.pn = (wgid % nig) / gsz; u.oa = 0; return true;
    }
    __device__ __forceinline__ void a_ready(const Unit&) const {}
    __device__ __forceinline__ void done(const Unit&) const {}
};

typedef float f32x2_cv __attribute__((ext_vector_type(2))); typedef __bf16 bf16x2_cv __attribute__((ext_vector_type(2)));
__device__ __forceinline__ unsigned cvt_pk_bf16(float lo, float hi) { f32x2_cv v = {lo, hi}; bf16x2_cv b = __builtin_convertvector(v, bf16x2_cv); return __builtin_bit_cast(unsigned, b); }
typedef unsigned u32x2 __attribute__((ext_vector_type(2)));
__device__ __forceinline__ float bf_lo(unsigned w) { return __uint_as_float(w << 16); }
__device__ __forceinline__ float bf_hi(unsigned w) { return __uint_as_float(w & 0xffff0000u); }
__device__ __forceinline__ float sigm(float x) { return __builtin_amdgcn_rcpf(1.0f + __expf(-x)); }
__device__ __forceinline__ u32x4 pack8(const float* o) { u32x4 w; w.x = cvt_pk_bf16(o[0], o[1]); w.y = cvt_pk_bf16(o[2], o[3]); w.z = cvt_pk_bf16(o[4], o[5]); w.w = cvt_pk_bf16(o[6], o[7]); return w; }

struct EpiSwiGLU {
    static constexpr bool PERM = true, AFTER_DRAIN = false;
    bf16_t* O; const float* ss;
    __device__ __forceinline__ void operator()(const f32x4 (&acc)[2][2][4][2], const Unit& u, int wr, int wc, int fr, int fq) const {
        const int row0 = u.pm * BM + wr * 64 + fr, col0 = u.pn * HALF + wc * 32 + 8 * fq;
        float rsv[8];
#pragma unroll
        for (int g = 0; g < 8; ++g) rsv[g] = ss[row0 + (g >> 2) * HALF + (g & 3) * 16];
        asm volatile("" : "+v"(rsv[0]), "+v"(rsv[1]), "+v"(rsv[2]), "+v"(rsv[3]), "+v"(rsv[4]), "+v"(rsv[5]), "+v"(rsv[6]), "+v"(rsv[7]));
#pragma unroll
        for (int ai = 0; ai < 2; ++ai)
#pragma unroll
            for (int m = 0; m < 4; ++m) {
                const int row = row0 + ai * HALF + m * 16;
                const float rs = rsqrtf(rsv[ai * 4 + m] * (1.0f / 2048.0f) + 1e-6f);
                float o[8];
#pragma unroll
                for (int n = 0; n < 2; ++n)
#pragma unroll
                    for (int e = 0; e < 4; ++e) { const float g = acc[ai][0][m][n][e] * rs, up = acc[ai][1][m][n][e] * rs; o[4 * n + e] = g * sigm(g) * up; }
                *(u32x4*)(O + (size_t)row * FFD + col0) = pack8(o);
            }
    }
};
template <bool IN_BF16, bool OUT_BF16> struct EpiResid {
    static constexpr bool PERM = true, AFTER_DRAIN = false;
    const float* xp; const float* xs; const bf16_t* xin_b; float* xo; bf16_t* xb; float* ss; float scale;
    __device__ __forceinline__ void operator()(const f32x4 (&acc)[2][2][4][2], const Unit& u, int wr, int wc, int fr, int fq) const {
        const int row0 = u.pm * BM + wr * 64 + fr, col0 = u.pn * BM + wc * 32 + 8 * fq;
        f32x4 xi[8][4]; u32x4 xw[8][2];
#define RES_LOAD(g) do { const int row_ = row0 + ((g) >> 2) * HALF + ((g) & 3) * 16; \
        if (IN_BF16) { const bf16_t* xin_ = xin_b + (size_t)row_ * DM; xw[g][0] = *(const u32x4*)(xin_ + col0); xw[g][1] = *(const u32x4*)(xin_ + col0 + HALF); } \
        else { const float* xin_ = (row_ < MP) ? xp + (size_t)row_ * DM : xs + (size_t)(row_ - MP) * DM; \
               xi[g][0] = *(const f32x4*)(xin_ + col0); xi[g][1] = *(const f32x4*)(xin_ + col0 + 4); xi[g][2] = *(const f32x4*)(xin_ + col0 + HALF); xi[g][3] = *(const f32x4*)(xin_ + col0 + HALF + 4); } } while (0)
        RES_LOAD(0); RES_LOAD(1);
#pragma unroll
        for (int g = 0; g < 8; ++g) {
            const int ai = g >> 2, m = g & 3, row = row0 + ai * HALF + m * 16;
            float sq = 0.f;
#pragma unroll
            for (int bj = 0; bj < 2; ++bj) {
                const int col = col0 + bj * HALF;
                float o[8];
                if (IN_BF16) { const u32x4 w = xw[g][bj]; o[0] = bf_lo(w.x); o[1] = bf_hi(w.x); o[2] = bf_lo(w.y); o[3] = bf_hi(w.y); o[4] = bf_lo(w.z); o[5] = bf_hi(w.z); o[6] = bf_lo(w.w); o[7] = bf_hi(w.w); }
                else { const f32x4 a0 = xi[g][2 * bj], a1 = xi[g][2 * bj + 1]; o[0] = a0[0]; o[1] = a0[1]; o[2] = a0[2]; o[3] = a0[3]; o[4] = a1[0]; o[5] = a1[1]; o[6] = a1[2]; o[7] = a1[3]; }
#pragma unroll
                for (int e = 0; e < 8; ++e) o[e] += acc[ai][bj][m][e >> 2][e & 3] * scale;
                if (OUT_BF16) *(u32x4*)(xb + (size_t)row * DM + col) = pack8(o);
                else { float* xout = xo + (size_t)row * DM + col; *(f32x4*)xout = (f32x4){o[0], o[1], o[2], o[3]}; *(f32x4*)(xout + 4) = (f32x4){o[4], o[5], o[6], o[7]}; }
#pragma unroll
                for (int e = 0; e < 8; ++e) sq += o[e] * o[e];
            }
            sq += __shfl_xor(sq, 16); sq += __shfl_xor(sq, 32);
            if (fq == 0) atomicAdd(ss + row, sq);
            if (g == 0) RES_LOAD(2); if (g == 1) RES_LOAD(3); if (g == 2) RES_LOAD(4); if (g == 3) RES_LOAD(5); if (g == 4) RES_LOAD(6); if (g == 5) RES_LOAD(7);
        }
#undef RES_LOAD
    }
};
struct EpiWin {
    static constexpr bool PERM = true, AFTER_DRAIN = false;
    const float* ss; bf16_t* QB; bf16_t* KB; bf16_t* VB; float* dout; bf16_t* U; bf16_t* GA; bf16_t* GB;
    __device__ __forceinline__ void operator()(const f32x4 (&acc)[2][2][4][2], const Unit& u, int wr, int wc, int fr, int fq) const {
        const int pn = u.pn, row0 = u.pm * BM + wr * 64 + fr, cl = wc * 32 + 8 * fq;
        float rsv[8];
#pragma unroll
        for (int g = 0; g < 8; ++g) rsv[g] = ss[row0 + (g >> 2) * HALF + (g & 3) * 16];
        asm volatile("" : "+v"(rsv[0]), "+v"(rsv[1]), "+v"(rsv[2]), "+v"(rsv[3]), "+v"(rsv[4]), "+v"(rsv[5]), "+v"(rsv[6]), "+v"(rsv[7]));
#pragma unroll
        for (int ai = 0; ai < 2; ++ai)
#pragma unroll
            for (int m = 0; m < 4; ++m) {
                const int row = row0 + ai * HALF + m * 16;
                const float rs = rsqrtf(rsv[ai * 4 + m] * (1.0f / 2048.0f) + 1e-6f);
#pragma unroll
                for (int bj = 0; bj < 2; ++bj) {
                    const int c = cl + bj * HALF;
                    float o[8];
#pragma unroll
                    for (int n = 0; n < 2; ++n)
#pragma unroll
                        for (int e = 0; e < 4; ++e) o[4 * n + e] = acc[ai][bj][m][n][e] * rs;
                    if (pn < 4) {
#pragma unroll
                        for (int e = 0; e < 8; ++e) o[e] *= QSCALE;
                        *(u32x4*)(QB + (size_t)row * 1024 + pn * 256 + c) = pack8(o);
                    } else if (pn < 12) {
                        const bool isk = pn < 8; const int col = (isk ? pn - 4 : pn - 8) * 256 + c;
                        float* fo = (row < MP) ? dout + (isk ? OFF_KP : OFF_VP) + (size_t)row * 1024 + col : dout + (isk ? OFF_KS : OFF_VS) + (size_t)(row - MP) * 1024 + col;
                        *(f32x4*)fo = (f32x4){o[0], o[1], o[2], o[3]}; *(f32x4*)(fo + 4) = (f32x4){o[4], o[5], o[6], o[7]};
                        if (row < MP) *(u32x4*)((isk ? KB : VB) + (size_t)row * 1024 + col) = pack8(o);
                    } else if (pn < 26) {
                        const int col = (pn - 12) * 256 + c;
                        *(u32x4*)(U + (size_t)row * 3584 + col) = pack8(o);
                        if (col < 3520) {
                            float* so = nullptr;
                            if (row < MP) { if ((row & 8191) == 8191) so = dout + OFF_SHP + (size_t)(row >> 13) * 3520 + col; }
                            else { if (((row - MP) & 63) == 63) so = dout + OFF_SHS + (size_t)((row - MP) >> 6) * 3520 + col; }
                            if (so) { *(f32x4*)so = (f32x4){o[0], o[1], o[2], o[3]}; *(f32x4*)(so + 4) = (f32x4){o[4], o[5], o[6], o[7]}; }
                        }
                    } else {
                        const bool isa = pn < 34; const int col = (isa ? pn - 26 : pn - 34) * 256 + c;
#pragma unroll
                        for (int e = 0; e < 8; ++e) o[e] = sigm(o[e]);
                        *(u32x4*)((isa ? GA : GB) + (size_t)row * DM + col) = pack8(o);
                    }
                }
            }
    }
};
struct EpiLora {
    static constexpr bool PERM = true, AFTER_DRAIN = false;
    const float* w0; const float* a0; bf16_t* LW; bf16_t* AS; bf16_t* GG;
    __device__ __forceinline__ void operator()(const f32x4 (&acc)[2][2][4][2], const Unit& u, int wr, int wc, int fr, int fq) const {
        const int pn = u.pn, row0 = u.pm * BM + wr * 64 + fr, cl = wc * 32 + 8 * fq;
        f32x4 bias[2][2];
#pragma unroll
        for (int bj = 0; bj < 2; ++bj) { const int col = (pn & 3) * 256 + cl + bj * HALF; const float* bp = (pn < 4) ? w0 + col : a0 + col;
            if (pn < 8) { bias[bj][0] = *(const f32x4*)bp; bias[bj][1] = *(const f32x4*)(bp + 4); } else { bias[bj][0] = (f32x4){0.f, 0.f, 0.f, 0.f}; bias[bj][1] = bias[bj][0]; } }
#pragma unroll
        for (int ai = 0; ai < 2; ++ai)
#pragma unroll
            for (int m = 0; m < 4; ++m) {
                const int row = row0 + ai * HALF + m * 16;
#pragma unroll
                for (int bj = 0; bj < 2; ++bj) {
                    const int col = (pn & 3) * 256 + cl + bj * HALF;
                    float o[8];
#pragma unroll
                    for (int n = 0; n < 2; ++n)
#pragma unroll
                        for (int e = 0; e < 4; ++e) o[4 * n + e] = acc[ai][bj][m][n][e] + bias[bj][n][e];
                    if (pn < 4) {
#pragma unroll
                        for (int e = 0; e < 8; ++e) { const float wv = -__logf(1.0f + __expf(-o[e])) - 0.5f; o[e] = -__expf(wv); }
                        *(u32x4*)(LW + (size_t)row * 1024 + col) = pack8(o);
                    } else if (pn < 8) {
#pragma unroll
                        for (int e = 0; e < 8; ++e) o[e] = sigm(o[e]);
                        *(u32x4*)(AS + (size_t)row * 1024 + col) = pack8(o);
                    } else {
                        *(u32x4*)(GG + (size_t)row * 1024 + col) = pack8(o);
                    }
                }
            }
    }
};
template <bool ADD> struct EpiProj {
    static constexpr bool PERM = true, AFTER_DRAIN = false;
    const bf16_t* GT; bf16_t* MG;
    __device__ __forceinline__ void operator()(const f32x4 (&acc)[2][2][4][2], const Unit& u, int wr, int wc, int fr, int fq) const {
        const int row0 = u.pm * BM + wr * 64 + fr, col0 = u.pn * BM + wc * 32 + 8 * fq;
        u32x4 gi[8][2], pi[8][2];
#define PRJ_LOAD(g) do { const size_t off_ = (size_t)(row0 + ((g) >> 2) * HALF + ((g) & 3) * 16) * DM + col0; gi[g][0] = *(const u32x4*)(GT + off_); gi[g][1] = *(const u32x4*)(GT + off_ + HALF); \
        if (ADD) { pi[g][0] = *(const u32x4*)(MG + off_); pi[g][1] = *(const u32x4*)(MG + off_ + HALF); } } while (0)
        PRJ_LOAD(0); PRJ_LOAD(1);
#pragma unroll
        for (int g = 0; g < 8; ++g) {
            const int ai = g >> 2, m = g & 3, row = row0 + ai * HALF + m * 16;
#pragma unroll
            for (int bj = 0; bj < 2; ++bj) {
                const size_t off = (size_t)row * DM + col0 + bj * HALF;
                const u32x4 gt = gi[g][bj];
                float o[8];
#pragma unroll
                for (int n = 0; n < 2; ++n)
#pragma unroll
                    for (int e = 0; e < 4; ++e) o[4 * n + e] = acc[ai][bj][m][n][e];
                o[0] *= bf_lo(gt.x); o[1] *= bf_hi(gt.x); o[2] *= bf_lo(gt.y); o[3] *= bf_hi(gt.y); o[4] *= bf_lo(gt.z); o[5] *= bf_hi(gt.z); o[6] *= bf_lo(gt.w); o[7] *= bf_hi(gt.w);
                if (ADD) { const u32x4 p = pi[g][bj];
                    o[0] += bf_lo(p.x); o[1] += bf_hi(p.x); o[2] += bf_lo(p.y); o[3] += bf_hi(p.y); o[4] += bf_lo(p.z); o[5] += bf_hi(p.z); o[6] += bf_lo(p.w); o[7] += bf_hi(p.w); }
                *(u32x4*)(MG + off) = pack8(o);
            }
            if (g == 0) PRJ_LOAD(2); if (g == 1) PRJ_LOAD(3); if (g == 2) PRJ_LOAD(4); if (g == 3) PRJ_LOAD(5); if (g == 4) PRJ_LOAD(6); if (g == 5) PRJ_LOAD(7);
        }
#undef PRJ_LOAD
    }
};

struct PanelOrder {
    int c, mode;
    __device__ __forceinline__ bool next(int i, Unit& u) const {
        if (mode == 0) { if (i >= 4) return false; const int x = c & 7, s = c >> 3; u.pm = i * 32 + x * 4 + (s >> 3); u.pn = s & 7; u.oa = 0; return true; }
        if (i >= 1 || c >= 64) return false; u.pm = 128 + (c & 7); u.pn = c >> 3; u.oa = 0; return true;
    }
    __device__ __forceinline__ void a_ready(const Unit&) const {}
    __device__ __forceinline__ void done(const Unit&) const {}
};
struct RangeOrder {
    int nM, nN, q, x, s, ns, base, cnt;
    __device__ __forceinline__ bool next(int i, Unit& u) const {
        const int j = s + ns * i; if (s < 0 || j >= cnt) return false;
        const int wgid = x * q + base + j, nig = WGM * nN, gid = wgid / nig, fm = gid * WGM, gsz = (nM - fm) < WGM ? (nM - fm) : WGM;
        u.pm = fm + ((wgid % nig) % gsz); u.pn = (wgid % nig) / gsz; u.oa = 0; return true;
    }
    __device__ __forceinline__ void a_ready(const Unit&) const {}
    __device__ __forceinline__ void done(const Unit&) const {}
};
struct LoraOrder {
    StaticOrder so;
    __device__ __forceinline__ bool next(int i, Unit& u) const { if (!so.next(i, u)) return false; u.oa = (u.pn >> 2) * (MROWS * 256 * 2); return true; }
    __device__ __forceinline__ void a_ready(const Unit&) const {}
    __device__ __forceinline__ void done(const Unit&) const {}
};
template <class Epi, class Sched, bool ALIGN_EPI = false, bool SP2 = false>
__device__ __forceinline__ void gemm_phase(PG8_LAS unsigned char* lds, const Gemm g, const Sched& S, const Epi& E) {
    const int tid = threadIdx.x, wid = __builtin_amdgcn_readfirstlane(tid >> 6), lane = tid & 63, wr = wid >> 2, wc = wid & 3, fr = lane & 15, fq = lane >> 4;
    const int K = g.K, nt = K / BK, lda = K;
    unsigned voffA[2], voffB[2];
#pragma unroll
    for (int i = 0; i < 2; ++i) { int R, C; stage_rc(tid * 16 + i * 8192, R, C); const int Rb = Epi::PERM ? ((R & ~31) + perm32(R & 31)) : R;
        voffA[i] = (unsigned)(R * lda + C) * 2u; voffB[i] = (unsigned)(Rb * K + C) * 2u; }
    const size_t kstep = (size_t)(BK * 2);
    const size_t hstep = (size_t)HALF * K * 2;
    const size_t tstep = 2 * hstep;
    const size_t hstepA = (size_t)HALF * lda * 2, tstepA = 2 * hstepA;
    const unsigned ldsw = (unsigned)wid * 1024u;
    const int aoff = lds_byte(wr * 64 + fr, fq * 8), boff = lds_byte(wc * 32 + fr, fq * 8);
#define PG8_SA(b, h) (((b) * 2 + (h)) * HTB)
#define PG8_SB(b, h) ((4 + (b) * 2 + (h)) * HTB)
#define PG8_STAGE(bufoff, gbase, voff) do { _Pragma("unroll") for (int _i = 0; _i < 2; ++_i) \
        __builtin_amdgcn_global_load_lds((const unsigned*)((const char*)(gbase) + (voff)[_i]), (PG8_LAS unsigned*)(lds + (bufoff) + ldsw + _i * 8192), 16, 0, 0); } while (0)
#define PG8_LDA(dst, b, h) do { _Pragma("unroll") for (int m = 0; m < 4; ++m) _Pragma("unroll") for (int k = 0; k < 2; ++k) dst[m][k] = *(const PG8_LAS bf16x8*)(lds + PG8_SA(b, h) + aoff + m * 2048 + k * 1024); } while (0)
#define PG8_LDB(dst, b, h) do { _Pragma("unroll") for (int n = 0; n < 2; ++n) _Pragma("unroll") for (int k = 0; k < 2; ++k) dst[n][k] = *(const PG8_LAS bf16x8*)(lds + PG8_SB(b, h) + boff + n * 2048 + k * 1024); } while (0)
#define PG8_MMA(ai, bj, At, Bt) do { __builtin_amdgcn_s_setprio(1); _Pragma("unroll") for (int m = 0; m < 4; ++m) _Pragma("unroll") for (int n = 0; n < 2; ++n) _Pragma("unroll") for (int k = 0; k < 2; ++k) \
        acc[ai][bj][m][n] = __builtin_amdgcn_mfma_f32_16x16x32_bf16(Bt[n][k], At[m][k], acc[ai][bj][m][n], 0, 0, 0); __builtin_amdgcn_s_setprio(0); } while (0)
#define PG8_WAIT_V(n) asm volatile("s_waitcnt vmcnt(" #n ")" ::: "memory")
#define PG8_WAIT_L(n) asm volatile("s_waitcnt lgkmcnt(" #n ")" ::: "memory")
#define PG8_BAR __builtin_amdgcn_s_barrier()
#define PG8_SCHED __builtin_amdgcn_sched_barrier(0)
    Unit cur, nxt; int ui = 0;
    if (!S.next(0, cur)) return;
    f32x4 acc[2][2][4][2];
#pragma unroll
    for (int a = 0; a < 2; ++a)
#pragma unroll
        for (int b = 0; b < 2; ++b)
#pragma unroll
            for (int m = 0; m < 4; ++m)
#pragma unroll
                for (int n = 0; n < 2; ++n) acc[a][b][m][n] = (f32x4){0.f, 0.f, 0.f, 0.f};
    bf16x8 At[4][2], B0[2][2], B1[2][2];
    const char* cA = (const char*)g.A + (size_t)cur.pm * tstepA + cur.oa; const char* cB = (const char*)g.Bt + (size_t)cur.pn * tstep;
    S.a_ready(cur);
    if constexpr (SP2) {
        PG8_STAGE(PG8_SB(0, 0), cB, voffB); PG8_STAGE(PG8_SB(0, 1), cB + hstep, voffB); PG8_STAGE(PG8_SA(0, 0), cA, voffA); PG8_STAGE(PG8_SA(0, 1), cA + hstepA, voffA);
        if (wr == 1) PG8_BAR;
        PG8_WAIT_V(2); PG8_BAR;
        PG8_STAGE(PG8_SB(1, 0), cB + kstep, voffB); PG8_STAGE(PG8_SA(1, 0), cA + kstep, voffA); PG8_STAGE(PG8_SB(1, 1), cB + hstep + kstep, voffB);
        PG8_WAIT_V(6); PG8_BAR;
    } else {
        PG8_STAGE(PG8_SB(0, 0), cB, voffB); PG8_STAGE(PG8_SA(0, 0), cA, voffA); PG8_STAGE(PG8_SB(0, 1), cB + hstep, voffB); PG8_STAGE(PG8_SA(0, 1), cA + hstepA, voffA);
        if (wr == 1) PG8_BAR;
        PG8_WAIT_V(4); PG8_BAR;
        PG8_STAGE(PG8_SB(1, 0), cB + kstep, voffB); PG8_STAGE(PG8_SA(1, 0), cA + kstep, voffA); PG8_STAGE(PG8_SB(1, 1), cB + hstep + kstep, voffB);
        PG8_WAIT_V(6); PG8_BAR;
    }
    for (;;) {
        const bool has_next = S.next(ui + 1, nxt);
        const char* nA = has_next ? (const char*)g.A + (size_t)nxt.pm * tstepA + nxt.oa : cA; const char* nB = has_next ? (const char*)g.Bt + (size_t)nxt.pn * tstep : cB;
#pragma unroll 1
        for (int t = 0; t < nt; t += 2) {
            const bool last = (t == nt - 2);
            const char* a1 = cA + (size_t)(t + 1) * kstep;
            const char* a2 = last ? nA : cA + (size_t)(t + 2) * kstep; const char* b2 = last ? nB : cB + (size_t)(t + 2) * kstep;
            const char* a3 = a2 + kstep; const char* b3 = b2 + kstep;
            if (last && has_next) S.a_ready(nxt);
            if constexpr (SP2) {
            PG8_LDB(B0, 0, 0); PG8_LDB(B1, 0, 1); PG8_SCHED; PG8_LDA(At, 0, 0); PG8_STAGE(PG8_SA(1, 1), a1 + hstepA, voffA);
            PG8_WAIT_V(8); PG8_WAIT_L(0); PG8_BAR; PG8_MMA(0, 0, At, B0); PG8_MMA(0, 1, At, B1); PG8_BAR; PG8_SCHED;
            PG8_LDA(At, 0, 1); PG8_STAGE(PG8_SB(0, 0), b2, voffB); PG8_STAGE(PG8_SB(0, 1), b2 + hstep, voffB); PG8_STAGE(PG8_SA(0, 0), a2, voffA);
            PG8_WAIT_V(8); PG8_WAIT_L(0); PG8_BAR; PG8_MMA(1, 0, At, B0); PG8_MMA(1, 1, At, B1); PG8_BAR; PG8_SCHED;
            PG8_LDB(B0, 1, 0); PG8_LDB(B1, 1, 1); PG8_SCHED; PG8_LDA(At, 1, 0); PG8_STAGE(PG8_SA(0, 1), a2 + hstepA, voffA);
            PG8_WAIT_V(8); PG8_WAIT_L(0); PG8_BAR; PG8_MMA(0, 0, At, B0); PG8_MMA(0, 1, At, B1); PG8_BAR; PG8_SCHED;
            PG8_LDA(At, 1, 1); PG8_STAGE(PG8_SB(1, 0), b3, voffB); PG8_STAGE(PG8_SB(1, 1), b3 + hstep, voffB); PG8_STAGE(PG8_SA(1, 0), a3, voffA);
            PG8_WAIT_V(8); PG8_WAIT_L(0); PG8_BAR; PG8_MMA(1, 0, At, B0); PG8_MMA(1, 1, At, B1); PG8_BAR; PG8_SCHED;
            } else {
            PG8_LDB(B0, 0, 0); PG8_SCHED; PG8_LDA(At, 0, 0); PG8_STAGE(PG8_SA(1, 1), a1 + hstepA, voffA);
            PG8_WAIT_L(8); PG8_BAR; PG8_WAIT_L(0); PG8_MMA(0, 0, At, B0); PG8_BAR; PG8_SCHED;
            PG8_LDB(B1, 0, 1); PG8_STAGE(PG8_SB(0, 0), b2, voffB);
            PG8_BAR; PG8_WAIT_L(0); PG8_MMA(0, 1, At, B1); PG8_BAR;
            PG8_LDA(At, 0, 1); PG8_STAGE(PG8_SA(0, 0), a2, voffA);
            PG8_BAR; PG8_WAIT_L(0); PG8_MMA(1, 0, At, B0); PG8_BAR; PG8_SCHED;
            PG8_STAGE(PG8_SB(0, 1), b2 + hstep, voffB);
            PG8_WAIT_V(6); PG8_BAR; PG8_MMA(1, 1, At, B1); PG8_BAR;
            PG8_LDB(B0, 1, 0); PG8_SCHED; PG8_LDA(At, 1, 0); PG8_STAGE(PG8_SA(0, 1), a2 + hstepA, voffA);
            PG8_WAIT_L(8); PG8_BAR; PG8_WAIT_L(0); PG8_MMA(0, 0, At, B0); PG8_BAR; PG8_SCHED;
            PG8_LDB(B1, 1, 1); PG8_STAGE(PG8_SB(1, 0), b3, voffB);
            PG8_BAR; PG8_WAIT_L(0); PG8_MMA(0, 1, At, B1); PG8_BAR;
            PG8_LDA(At, 1, 1); PG8_STAGE(PG8_SA(1, 0), a3, voffA);
            PG8_BAR; PG8_WAIT_L(0); PG8_MMA(1, 0, At, B0); PG8_BAR; PG8_SCHED;
            PG8_STAGE(PG8_SB(1, 1), b3 + hstep, voffB);
            PG8_WAIT_V(6); PG8_BAR; PG8_MMA(1, 1, At, B1); PG8_BAR;
            }
        }
        if constexpr (ALIGN_EPI) { if (wr == 0) PG8_BAR; }
        if constexpr (!Epi::AFTER_DRAIN) { E(acc, cur, wr, wc, fr, fq); S.done(cur); }
        if (!has_next) break;
#pragma unroll
        for (int a = 0; a < 2; ++a)
#pragma unroll
            for (int b = 0; b < 2; ++b)
#pragma unroll
                for (int m = 0; m < 4; ++m)
#pragma unroll
                    for (int n = 0; n < 2; ++n) acc[a][b][m][n] = (f32x4){0.f, 0.f, 0.f, 0.f};
        cur = nxt; cA = nA; cB = nB; ++ui;
        if constexpr (ALIGN_EPI) { if (wr == 1) PG8_BAR; }
    }
    PG8_WAIT_V(0);
    if constexpr (!ALIGN_EPI) { if (wr == 0) PG8_BAR; }
    PG8_BAR;
    if constexpr (Epi::AFTER_DRAIN) { E.fused(acc, cur, wr, wc, fr, fq, lds, wid, lane); S.done(cur); }
#undef PG8_SA
#undef PG8_SB
#undef PG8_STAGE
#undef PG8_LDA
#undef PG8_LDB
#undef PG8_MMA
#undef PG8_WAIT_V
#undef PG8_WAIT_L
#undef PG8_BAR
#undef PG8_SCHED
}
}
#define LAS __attribute__((address_space(3)))
#define GAS __attribute__((address_space(1)))
typedef unsigned short bf16_t;
typedef short bf16x8 __attribute__((ext_vector_type(8)));
typedef short s16x4 __attribute__((ext_vector_type(4)));
typedef float f32x4 __attribute__((ext_vector_type(4)));
typedef float f32x16 __attribute__((ext_vector_type(16)));
typedef unsigned u32x4 __attribute__((ext_vector_type(4)));
typedef unsigned u32x2 __attribute__((ext_vector_type(2)));
typedef float f32x2_t __attribute__((ext_vector_type(2)));
typedef __bf16 bf16x2_t __attribute__((ext_vector_type(2)));
__device__ __forceinline__ unsigned cvtpk(float lo, float hi) { f32x2_t v = {lo, hi}; bf16x2_t b = __builtin_convertvector(v, bf16x2_t); return __builtin_bit_cast(unsigned, b); }
__device__ __forceinline__ u32x4 pk8(const float* o) { u32x4 w; w.x = cvtpk(o[0], o[1]); w.y = cvtpk(o[2], o[3]); w.z = cvtpk(o[4], o[5]); w.w = cvtpk(o[6], o[7]); return w; }
__device__ __forceinline__ float bflo(unsigned w) { return __uint_as_float(w << 16); }
__device__ __forceinline__ float bfhi(unsigned w) { return __uint_as_float(w & 0xffff0000u); }
__device__ __forceinline__ void unpk8(const u32x4 w, float* o) { o[0] = bflo(w.x); o[1] = bfhi(w.x); o[2] = bflo(w.y); o[3] = bfhi(w.y); o[4] = bflo(w.z); o[5] = bfhi(w.z); o[6] = bflo(w.w); o[7] = bfhi(w.w); }
__device__ __forceinline__ int crow(int r, int hi) { return (r & 3) + 8 * (r >> 2) + 4 * hi; }
__device__ __forceinline__ float swap_add(float v) { auto rr = __builtin_amdgcn_permlane32_swap(__float_as_uint(v), __float_as_uint(v), false, false); return __uint_as_float(rr[0]) + __uint_as_float(rr[1]); }
__device__ __forceinline__ float swap_max(float v) { auto rr = __builtin_amdgcn_permlane32_swap(__float_as_uint(v), __float_as_uint(v), false, false); return fmaxf(__uint_as_float(rr[0]), __uint_as_float(rr[1])); }
#define WG_BAR() do { asm volatile("s_waitcnt lgkmcnt(0)" ::: "memory"); __builtin_amdgcn_s_barrier(); asm volatile("" ::: "memory"); } while (0)
typedef short v4i16_t __attribute__((ext_vector_type(4)));
typedef unsigned long long u64x2 __attribute__((ext_vector_type(2)));
__device__ __forceinline__ unsigned long long vtr64(const LAS unsigned char* p) { return __builtin_bit_cast(unsigned long long, __builtin_amdgcn_ds_read_tr16_b64_v4i16((LAS v4i16_t*)p)); }
__device__ __forceinline__ s16x4 vtr(const LAS unsigned char* p) { return __builtin_bit_cast(s16x4, __builtin_amdgcn_ds_read_tr16_b64_v4i16((LAS v4i16_t*)p)); }

namespace att {
constexpr int KT = 16384, BUF = 32768, CBS = 132, WSF_OFF = 3 * BUF, LDS_NEED = WSF_OFF + 8 * 256;
struct Src { const void* k; const void* v; const float* kn; const float* vn; };
template <bool F32> struct Stage;
template <> struct Stage<false> { u32x4 k[2], v[2]; };
template <> struct Stage<true> { f32x4 k[2][2], v[2][2]; };

template <bool F32> __device__ __forceinline__ void tile_load(Stage<F32>& s, const Src& S, int t, int wid, int lane) {
    if constexpr (F32) {
        const float* kb = (t < 64) ? (const float*)S.k + (size_t)t * 65536 : S.kn;
        const float* vb = (t < 64) ? (const float*)S.v + (size_t)t * 65536 : S.vn;
#pragma unroll
        for (int i = 0; i < 2; ++i) { const float* p = kb + (size_t)lane * 1024 + (wid + 8 * i) * 8; s.k[i][0] = *(const f32x4*)p; s.k[i][1] = *(const f32x4*)(p + 4); }
#pragma unroll
        for (int i = 0; i < 2; ++i) { const int pp = wid + 8 * i, db = pp >> 2, kg = pp & 3; const float* p = vb + (size_t)(16 * kg + (lane >> 2)) * 1024 + db * 32 + (lane & 3) * 8; s.v[i][0] = *(const f32x4*)p; s.v[i][1] = *(const f32x4*)(p + 4); }
    } else {
        const bf16_t* kb = (const bf16_t*)S.k + (size_t)t * 65536;
        const bf16_t* vb = (const bf16_t*)S.v + (size_t)t * 65536;
#pragma unroll
        for (int i = 0; i < 2; ++i) s.k[i] = *(const u32x4*)(kb + (size_t)lane * 1024 + (wid + 8 * i) * 8);
#pragma unroll
        for (int i = 0; i < 2; ++i) { const int pp = wid + 8 * i, db = pp >> 2, kg = pp & 3; s.v[i] = *(const u32x4*)(vb + (size_t)(16 * kg + (lane >> 2)) * 1024 + db * 32 + (lane & 3) * 8); }
    }
}
template <bool F32> __device__ __forceinline__ void tile_store(const Stage<F32>& s, LAS unsigned char* buf, int wid, int lane) {
#pragma unroll
    for (int i = 0; i < 2; ++i) {
        u32x4 kv, vv;
        if constexpr (F32) { float a[8] = {s.k[i][0][0], s.k[i][0][1], s.k[i][0][2], s.k[i][0][3], s.k[i][1][0], s.k[i][1][1], s.k[i][1][2], s.k[i][1][3]}; kv = pk8(a);
                             float b[8] = {s.v[i][0][0], s.v[i][0][1], s.v[i][0][2], s.v[i][0][3], s.v[i][1][0], s.v[i][1][1], s.v[i][1][2], s.v[i][1][3]}; vv = pk8(b); }
        else { kv = s.k[i]; vv = s.v[i]; }
        *(LAS u32x4*)(buf + (wid + 8 * i) * 1024 + lane * 16) = kv;
        *(LAS u32x4*)(buf + KT + (wid + 8 * i) * 1024 + lane * 16) = vv;
    }
}

template <bool F32>
__device__ __forceinline__ void unit(LAS unsigned char* lds, const bf16_t* Qu, const Src& S, int nt_lo, int nt_hi, bf16_t* Ou, float lam, const float* subg) {
    const int tid = threadIdx.x, lane = tid & 63, wid = __builtin_amdgcn_readfirstlane(tid >> 6), r32 = lane & 31, hi = lane >> 5;
    const int c = F32 ? ((wid >> 1) & 1) : (wid >> 2), rb = F32 ? ((wid < 4) ? (wid & 1) : 2 + (wid & 1)) : (wid & 3);
    const int ntw = (rb < 2) ? nt_lo : nt_hi, NT = nt_lo > nt_hi ? nt_lo : nt_hi;
    const bool active = ntw > 0, late = c == 1;
    bf16x8 qr[4];
#pragma unroll
    for (int d0 = 0; d0 < 4; ++d0) { if (active) qr[d0] = *(const bf16x8*)(Qu + (size_t)(32 * rb + r32) * 1024 + c * 64 + d0 * 16 + hi * 8); else qr[d0] = (bf16x8){0, 0, 0, 0, 0, 0, 0, 0}; }
    float mrun = 0.f, l = 0.f;
    f32x16 o[4];
#pragma unroll
    for (int d0 = 0; d0 < 4; ++d0)
#pragma unroll
        for (int r = 0; r < 16; ++r) o[d0][r] = 0.f;
    bf16x8 pa[4];
#pragma unroll
    for (int ks = 0; ks < 4; ++ks) pa[ks] = (bf16x8){0, 0, 0, 0, 0, 0, 0, 0};
    f32x16 negm;
#pragma unroll
    for (int r = 0; r < 16; ++r) negm[r] = 0.f;
    asm volatile("" : "+v"(negm));
    LAS float* wsf = (LAS float*)(lds + WSF_OFF + wid * 256);
    Stage<F32> st;
    tile_load<F32>(st, S, 0, wid, lane);
    tile_store<F32>(st, lds, wid, lane);
    if (NT > 1) tile_load<F32>(st, S, 1, wid, lane);
    WG_BAR();
    const int vlane = ((lane >> 4) & 1) * 32 + (lane & 3) * 8 + (4 * hi + ((lane & 15) >> 2)) * 64;
#define ATT_PV(bufp) do { const LAS unsigned char* vp_ = (bufp) + KT + vlane; \
        _Pragma("unroll") for (int d0 = 0; d0 < 4; ++d0) \
            _Pragma("unroll") for (int ks = 0; ks < 4; ++ks) { \
                u64x2 vq_; vq_.x = vtr64(vp_ + d0 * 4096 + ks * 1024); vq_.y = vtr64(vp_ + d0 * 4096 + ks * 1024 + 512);     \
                o[d0] = __builtin_amdgcn_mfma_f32_32x32x16_bf16(pa[ks], __builtin_bit_cast(bf16x8, vq_), o[d0], 0, 0, 0); } } while (0)
    int b_cur = 0, b_prev = 2 * BUF, b_next = BUF;
    for (int t = 0; t <= NT; ++t) {
        if (t + 1 < NT) tile_store<F32>(st, lds + b_next, wid, lane);
        if (t + 2 < NT) tile_load<F32>(st, S, t + 2, wid, lane);
        if (late && t >= 1 && t - 1 < ntw) ATT_PV(lds + b_prev);
        if (t < ntw) {
            LAS unsigned char* buf = lds + b_cur;
            f32x16 p0, p1;
            const LAS unsigned char* kb = buf + (8 * c + hi) * 1024 + r32 * 16;
#pragma unroll
            for (int d0 = 0; d0 < 4; ++d0) {
                const bf16x8 b0 = *(const LAS bf16x8*)(kb + d0 * 2048), b1 = *(const LAS bf16x8*)(kb + d0 * 2048 + 512);
                if (d0 == 0) { p0 = __builtin_amdgcn_mfma_f32_32x32x16_bf16(b0, qr[0], negm, 0, 0, 0); p1 = __builtin_amdgcn_mfma_f32_32x32x16_bf16(b1, qr[0], negm, 0, 0, 0); }
                else { p0 = __builtin_amdgcn_mfma_f32_32x32x16_bf16(b0, qr[d0], p0, 0, 0, 0); p1 = __builtin_amdgcn_mfma_f32_32x32x16_bf16(b1, qr[d0], p1, 0, 0, 0); }
            }
            float rm = fmaxf(fmaxf(p0[0], p0[1]), p1[0]);
#pragma unroll
            for (int r = 2; r < 16; r += 2) rm = fmaxf(fmaxf(rm, p0[r]), p0[r + 1]);
            rm = fmaxf(rm, p1[1]);
#pragma unroll
            for (int r = 2; r < 16; r += 2) rm = fmaxf(fmaxf(rm, p1[r]), p1[r + 1]);
            rm = swap_max(rm);
            if (t == 0 || __any(rm > 8.0f)) {
                const float dl = (t == 0) ? rm : fmaxf(rm, 0.f), alpha = (t == 0) ? 1.0f : __builtin_amdgcn_exp2f(-dl);
                mrun += dl; l *= alpha;
#pragma unroll
                for (int r = 0; r < 16; ++r) negm[r] = -mrun;
                asm volatile("" : "+v"(negm));
                if (hi == 0) wsf[r32] = alpha;
#pragma unroll
                for (int r = 0; r < 16; ++r) { p0[r] -= dl; p1[r] -= dl; const float f = wsf[crow(r, hi)];
#pragma unroll
                    for (int d0 = 0; d0 < 4; ++d0) o[d0][r] *= f; }
            }
            float sacc = 0.f;
#pragma unroll
            for (int r = 0; r < 16; ++r) { p0[r] = __builtin_amdgcn_exp2f(p0[r]); p1[r] = __builtin_amdgcn_exp2f(p1[r]); sacc += p0[r]; asm volatile("" : "+v"(sacc)); sacc += p1[r]; asm volatile("" : "+v"(sacc)); }
            l += sacc;
            { u32x4 w;
              w.x = cvtpk(p0[0], p0[1]); w.y = cvtpk(p0[2], p0[3]); w.z = cvtpk(p0[4], p0[5]); w.w = cvtpk(p0[6], p0[7]); pa[0] = __builtin_bit_cast(bf16x8, w);
              w.x = cvtpk(p0[8], p0[9]); w.y = cvtpk(p0[10], p0[11]); w.z = cvtpk(p0[12], p0[13]); w.w = cvtpk(p0[14], p0[15]); pa[1] = __builtin_bit_cast(bf16x8, w);
              w.x = cvtpk(p1[0], p1[1]); w.y = cvtpk(p1[2], p1[3]); w.z = cvtpk(p1[4], p1[5]); w.w = cvtpk(p1[6], p1[7]); pa[2] = __builtin_bit_cast(bf16x8, w);
              w.x = cvtpk(p1[8], p1[9]); w.y = cvtpk(p1[10], p1[11]); w.z = cvtpk(p1[12], p1[13]); w.w = cvtpk(p1[14], p1[15]); pa[3] = __builtin_bit_cast(bf16x8, w); }
            if (!late) ATT_PV(buf);
        }
        WG_BAR();
        { const int tmp = b_prev; b_prev = b_cur; b_cur = b_next; b_next = tmp; }
    }
#undef ATT_PV
    if (active) {
        const float lt = swap_add(l), inv = 1.0f / lt;
        if (hi == 0) wsf[r32] = inv;
#pragma unroll
        for (int r = 0; r < 16; ++r) { const float f = wsf[crow(r, hi)];
#pragma unroll
            for (int d0 = 0; d0 < 4; ++d0) o[d0][r] *= f; }
    }
    LAS float* cb = (LAS float*)lds;
    if (active && c == 1) {
#pragma unroll
        for (int d0 = 0; d0 < 4; ++d0)
#pragma unroll
            for (int r = 0; r < 16; ++r) cb[(32 * rb + crow(r, hi)) * CBS + 32 * d0 + r32] = o[d0][r];
    }
    WG_BAR();
    if (active && c == 0) {
#pragma unroll
        for (int d0 = 0; d0 < 4; ++d0)
#pragma unroll
            for (int r = 0; r < 16; ++r) { const int idx = (32 * rb + crow(r, hi)) * CBS + 32 * d0 + r32; cb[idx] = o[d0][r] - lam * cb[idx]; }
        asm volatile("s_waitcnt lgkmcnt(0)" ::: "memory");
        const int q = 32 * rb + r32;
        f32x4 vals[16]; float ssq = 0.f;
#pragma unroll
        for (int j = 0; j < 16; ++j) { vals[j] = *(const LAS f32x4*)(cb + q * CBS + 64 * hi + 4 * j); ssq += vals[j][0] * vals[j][0] + vals[j][1] * vals[j][1] + vals[j][2] * vals[j][2] + vals[j][3] * vals[j][3]; }
        ssq = swap_add(ssq);
        const float rs = rsqrtf(ssq * (1.0f / 128.0f) + 1e-5f) * 0.8f;
#pragma unroll
        for (int j = 0; j < 16; j += 2) {
            const f32x4 g0 = *(const f32x4*)(subg + 64 * hi + 4 * j), g1 = *(const f32x4*)(subg + 64 * hi + 4 * j + 4);
            float ov[8] = {vals[j][0] * rs * g0[0], vals[j][1] * rs * g0[1], vals[j][2] * rs * g0[2], vals[j][3] * rs * g0[3],
                           vals[j + 1][0] * rs * g1[0], vals[j + 1][1] * rs * g1[1], vals[j + 1][2] * rs * g1[2], vals[j + 1][3] * rs * g1[3]};
            *(u32x4*)(Ou + (size_t)q * 1024 + 64 * hi + 4 * j) = pk8(ov);
        }
    }
    WG_BAR();
}
}
namespace rw {
constexpr int STR = 144, MAT = 64 * STR, FSTR = 68;
constexpr int O_AT = 0, O_BB = MAT, O_RT = 2 * MAT, O_KB = 3 * MAT, O_VT = 4 * MAT, O_BCT = 5 * MAT, O_KCT = 6 * MAT, O_AAK = 7 * MAT, O_ARB = 8 * MAT, O_ARK = 9 * MAT;
constexpr int O_P = 10 * MAT, O_PT = 11 * MAT, O_CS = O_P, O_GC = 12 * MAT, O_P1T = O_BB, O_Q1T = O_KB, PT_OFF = O_GC + 256, LDS_NEED = PT_OFF + 24576;
constexpr int UNIT_BYTES = 32768, UO_G = 0, UO_HT = 8192, UO_Y1 = 16384, UO_Y0 = 24576;
constexpr int NUNITS = 8704, NPROMPT_UNITS = 8192;

struct Args {
    const bf16_t* U; const bf16_t* LW; const bf16_t* AS; const bf16_t* GG; const float* mu; const float* shift_in; const float* state_in;
    const float* k_k; const float* k_a; const float* r_k; const float* lnx_g; const float* lnx_b;
    unsigned char* AOUT; bf16_t* S0; float* RK; bf16_t* OB; float* dout;
};

__device__ __forceinline__ bf16x8 frag_tr(const LAS unsigned char* img, int q, int ks, int lane) {
    const int i16 = lane & 15, g1 = (lane >> 4) & 1, hi = lane >> 5;
    const LAS unsigned char* p = img + (16 * ks + 8 * hi + (i16 >> 2)) * STR + (32 * q + 16 * g1 + 4 * (i16 & 3)) * 2;
    u64x2 v; v.x = vtr64(p); v.y = vtr64(p + 4 * STR); return __builtin_bit_cast(bf16x8, v);
}
template <bool NT = false, bool MT = false>
__device__ __forceinline__ f32x16 mm_tile(const LAS unsigned char* N, const LAS unsigned char* M, int qn, int qm, int r32, int hi, f32x16 acc) {
    const int lane = r32 + 32 * hi;
    const LAS unsigned char* pa = N + (32 * qn + r32) * STR + hi * 16;
    const LAS unsigned char* pb = M + (32 * qm + r32) * STR + hi * 16;
#pragma unroll
    for (int ks = 0; ks < 4; ++ks) {
        const bf16x8 a = NT ? frag_tr(N, qn, ks, lane) : *(const LAS bf16x8*)(pa + ks * 32);
        const bf16x8 b = MT ? frag_tr(M, qm, ks, lane) : *(const LAS bf16x8*)(pb + ks * 32);
        acc = __builtin_amdgcn_mfma_f32_32x32x16_bf16(a, b, acc, 0, 0, 0);
    }
    return acc;
}
__device__ __forceinline__ f32x16 zero16() { f32x16 z;
#pragma unroll
    for (int r = 0; r < 16; ++r) z[r] = 0.f; return z; }
__device__ __forceinline__ void shifted8(const Args& A, int row, int col, bool first, bool sample, int b, float* out) {
    float u[8], p[8];
    unpk8(*(const u32x4*)(A.U + (size_t)row * 3584 + col), u);
    if (!first) unpk8(*(const u32x4*)(A.U + (size_t)(row - 1) * 3584 + col), p);
    else if (sample) { const f32x4 a = *(const f32x4*)(A.shift_in + (size_t)b * 3520 + col), c = *(const f32x4*)(A.shift_in + (size_t)b * 3520 + col + 4); p[0] = a[0]; p[1] = a[1]; p[2] = a[2]; p[3] = a[3]; p[4] = c[0]; p[5] = c[1]; p[6] = c[2]; p[7] = c[3]; }
    else {
#pragma unroll
        for (int e = 0; e < 8; ++e) p[e] = 0.f; }
    const f32x4 m0 = *(const f32x4*)(A.mu + col), m1 = *(const f32x4*)(A.mu + col + 4);
#pragma unroll
    for (int e = 0; e < 8; ++e) { const float mv = e < 4 ? m0[e & 3] : m1[e & 3]; out[e] = u[e] + mv * (p[e] - u[e]); }
}
__device__ __forceinline__ void unit_decode(int u, int& b, int& h, int& row0, bool& sample, bool& firstchunk) {
    if (u < NPROMPT_UNITS) { const int bh = u >> 7, c = u & 127; b = bh >> 4; h = bh & 15; row0 = b * 8192 + c * 64; sample = false; firstchunk = (c == 0); }
    else { const int bh = u - NPROMPT_UNITS; b = bh >> 4; h = bh & 15; row0 = MP + b * 64; sample = true; firstchunk = true; }
}

__device__ __forceinline__ int unit_of(int w) { if (w >= NPROMPT_UNITS) return w; const int h = w & 15, c = (w >> 4) & 127, b = w >> 11; return ((b * 16 + h) << 7) + c; }
struct PrepIn { u32x4 ur, urp, uk, ukp, uv, uvp, asb, lwb; };
__device__ __forceinline__ u32x4 prev_row8(const Args& A, int row, int col) { const int rp = row > 0 ? row - 1 : 0; return *(const u32x4*)(A.U + (size_t)rp * 3584 + col); }
__device__ __forceinline__ u32x4 fix_first8(const Args& A, u32x4 prv, int col, bool first, bool sample, int b) {
    if (first) {
        if (sample) { const f32x4 a = *(const f32x4*)(A.shift_in + (size_t)b * 3520 + col), c = *(const f32x4*)(A.shift_in + (size_t)b * 3520 + col + 4);
            float p[8] = {a[0], a[1], a[2], a[3], c[0], c[1], c[2], c[3]}; prv = pk8(p); }
        else prv = (u32x4){0u, 0u, 0u, 0u};
    }
    return prv;
}
__device__ __forceinline__ void prep_load(const Args& A, int u, PrepIn& in) {
    const int tid = threadIdx.x; int b, h, row0; bool sample, firstchunk; unit_decode(u, b, h, row0, sample, firstchunk);
    const int t = tid >> 3, j0 = 8 * (tid & 7), row = row0 + t, cr = h * 64 + j0;
    const bf16_t* ur = A.U + (size_t)row * 3584 + cr;
    in.ur = *(const u32x4*)ur; in.uk = *(const u32x4*)(ur + 1024); in.uv = *(const u32x4*)(ur + 2048);
    in.urp = prev_row8(A, row, cr); in.ukp = prev_row8(A, row, 1024 + cr); in.uvp = prev_row8(A, row, 2048 + cr);
    in.lwb = *(const u32x4*)(A.LW + (size_t)row * 1024 + cr); in.asb = *(const u32x4*)(A.AS + (size_t)row * 1024 + cr);
}
__device__ __forceinline__ void mix8(const u32x4 cur, const u32x4 prv, const float* mu, float* out) {
    float u[8], p[8]; unpk8(cur, u); unpk8(prv, p);
    const f32x4 m0 = *(const f32x4*)mu, m1 = *(const f32x4*)(mu + 4);
#pragma unroll
    for (int e = 0; e < 8; ++e) { const float mv = e < 4 ? m0[e & 3] : m1[e & 3]; out[e] = u[e] + mv * (p[e] - u[e]); }
}
__device__ __forceinline__ void ld8l(const LAS float* p, float* o) { const f32x4 a = *(const LAS f32x4*)p, c = *(const LAS f32x4*)(p + 4); o[0] = a[0]; o[1] = a[1]; o[2] = a[2]; o[3] = a[3]; o[4] = c[0]; o[5] = c[1]; o[6] = c[2]; o[7] = c[3]; }
__device__ __forceinline__ void mix8l(const u32x4 cur, const u32x4 prv, const LAS float* mu, float* out) {
    float u[8], p[8], m[8]; unpk8(cur, u); unpk8(prv, p); ld8l(mu, m);
#pragma unroll
    for (int e = 0; e < 8; ++e) out[e] = u[e] + m[e] * (p[e] - u[e]);
}
__device__ __forceinline__ void ld8(const float* p, float* o) { const f32x4 a = *(const f32x4*)p, c = *(const f32x4*)(p + 4); o[0] = a[0]; o[1] = a[1]; o[2] = a[2]; o[3] = a[3]; o[4] = c[0]; o[5] = c[1]; o[6] = c[2]; o[7] = c[3]; }

__device__ __forceinline__ void stage_a(LAS unsigned char* lds, const Args& A, int u, PrepIn& in, int u_next) {
    const int tid = threadIdx.x, lane = tid & 63, wid = __builtin_amdgcn_readfirstlane(tid >> 6), r32 = lane & 31, hi = lane >> 5;
    int b, h, row0; bool sample, firstchunk; unit_decode(u, b, h, row0, sample, firstchunk);
    LAS float* CS = (LAS float*)(lds + O_CS); LAS float* GC = (LAS float*)(lds + O_GC);
    {
        const int t = tid >> 3, jg = tid & 7, j0 = 8 * jg, row = row0 + t, cr = h * 64 + j0;
        float r[8], k[8], v[8], lw[8], as[8], L[8];
        float kkp[8], kap[8], rkp[8];
        const LAS float* ptab = (const LAS float*)(lds + PT_OFF) + h * 384 + j0;
        ld8l(ptab, kkp); ld8l(ptab + 64, kap); ld8l(ptab + 128, rkp);
        const bool first = firstchunk && t == 0;
        mix8l(in.ur, fix_first8(A, in.urp, cr, first, sample, b), ptab + 192, r); mix8l(in.uk, fix_first8(A, in.ukp, 1024 + cr, first, sample, b), ptab + 256, k); mix8l(in.uv, fix_first8(A, in.uvp, 2048 + cr, first, sample, b), ptab + 320, v);
        unpk8(in.lwb, lw);
        unpk8(in.asb, as);
#define RW_PIN8(a) asm volatile("" : "+v"(a[0]), "+v"(a[1]), "+v"(a[2]), "+v"(a[3]), "+v"(a[4]), "+v"(a[5]), "+v"(a[6]), "+v"(a[7]))
        RW_PIN8(r); RW_PIN8(k); RW_PIN8(v); RW_PIN8(kkp); RW_PIN8(kap); RW_PIN8(rkp); RW_PIN8(lw); RW_PIN8(as);
#undef RW_PIN8
        asm volatile("" ::: "memory");
        if (u_next >= 0) prep_load(A, u_next, in);
        asm volatile("" ::: "memory");
#pragma unroll
        for (int e = 0; e < 8; ++e) { float x = lw[e];
            float y = __shfl_up(x, 8); if (lane >= 8) x += y; y = __shfl_up(x, 16); if (lane >= 16) x += y; y = __shfl_up(x, 32); if (lane >= 32) x += y; L[e] = x; }
        if (lane >= 56) { *(LAS f32x4*)(CS + wid * 64 + j0) = (f32x4){L[0], L[1], L[2], L[3]}; *(LAS f32x4*)(CS + wid * 64 + j0 + 4) = (f32x4){L[4], L[5], L[6], L[7]}; }
        WG_BAR();
        float LC[8];
#pragma unroll
        for (int e = 0; e < 8; ++e) LC[e] = 0.f;
#pragma unroll
        for (int w = 0; w < 8; ++w) { const f32x4 a = *(const LAS f32x4*)(CS + w * 64 + j0), c = *(const LAS f32x4*)(CS + w * 64 + j0 + 4);
            const float tot[8] = {a[0], a[1], a[2], a[3], c[0], c[1], c[2], c[3]};
#pragma unroll
            for (int e = 0; e < 8; ++e) { LC[e] += tot[e]; if (w < wid) L[e] += tot[e]; } }
        if (t == 63) {
#pragma unroll
            for (int e = 0; e < 8; ++e) GC[j0 + e] = __expf(LC[e]); }
        float kk[8], km[8], bb[8]; float ssq = 0.f, rk = 0.f;
#pragma unroll
        for (int e = 0; e < 8; ++e) { kk[e] = k[e] * kkp[e]; ssq += kk[e] * kk[e]; }
        ssq += __shfl_xor(ssq, 1); ssq += __shfl_xor(ssq, 2); ssq += __shfl_xor(ssq, 4);
        const float inv = rsqrtf(fmaxf(ssq, 1e-24f));
        float oR[8], oA[8], oK[8], oB[8], oBc[8], oKc[8];
#pragma unroll
        for (int e = 0; e < 8; ++e) {
            kk[e] *= inv; km[e] = k[e] * (1.0f + (as[e] - 1.0f) * kap[e]); bb[e] = kk[e] * as[e];
            rk += r[e] * km[e] * rkp[e];
            const float g = __expf(L[e]), gp = __expf(L[e] - lw[e]), gi = __expf(-L[e]), gc = __expf(LC[e] - L[e]);
            oR[e] = r[e] * g; oA[e] = -kk[e] * gp; oK[e] = km[e] * gi; oB[e] = bb[e] * gi;
            oBc[e] = bb[e] * gc; oKc[e] = km[e] * gc;
        }
        rk += __shfl_xor(rk, 1); rk += __shfl_xor(rk, 2); rk += __shfl_xor(rk, 4);
        if (jg == 0) A.RK[(size_t)row * 16 + h] = rk;
        *(LAS u32x4*)(lds + O_RT + t * STR + j0 * 2) = pk8(oR); *(LAS u32x4*)(lds + O_AT + t * STR + j0 * 2) = pk8(oA);
        *(LAS u32x4*)(lds + O_KB + t * STR + j0 * 2) = pk8(oK); *(LAS u32x4*)(lds + O_BB + t * STR + j0 * 2) = pk8(oB);
        *(LAS u32x4*)(lds + O_BCT + t * STR + j0 * 2) = pk8(oBc); *(LAS u32x4*)(lds + O_KCT + t * STR + j0 * 2) = pk8(oKc); *(LAS u32x4*)(lds + O_VT + t * STR + j0 * 2) = pk8(v);
    }
    WG_BAR();
    for (int job = wid; job < 16; job += 8) {
        const int prod = job >> 2, qn = (job >> 1) & 1, qm = job & 1;
        const LAS unsigned char* Nm = lds + (prod == 4 ? O_AT : (prod & 1) ? O_KB : O_BB);
        const LAS unsigned char* Mm = lds + (prod == 4 ? O_BB : (prod & 2) ? O_RT : O_AT);
        const f32x16 acc = mm_tile(Nm, Mm, qn, qm, r32, hi, zero16());
        const int ri = 32 * qm + r32, sgn = (prod == 4) ? -1 : 1, lim = (prod == 2 || prod == 3) ? 1 : 0;
        LAS unsigned char* dst = lds + (prod == 0 ? O_P : prod == 1 ? O_AAK : prod == 2 ? O_ARB : prod == 3 ? O_ARK : O_PT) + ri * STR;
#pragma unroll
        for (int g = 0; g < 4; ++g) {
            const int c0 = 32 * qn + 8 * g + 4 * hi; float o4[4];
#pragma unroll
            for (int e = 0; e < 4; ++e) { const int ci = c0 + e; o4[e] = (sgn * (ci - ri) < lim) ? acc[4 * g + e] : 0.f; }
            u32x2 w; w.x = cvtpk(o4[0], o4[1]); w.y = cvtpk(o4[2], o4[3]); *(LAS u32x2*)(dst + c0 * 2) = w;
        }
    }
    WG_BAR();
    {
        const int qm = wid >> 1, qn = wid & 1;
        LAS unsigned char* ximg = lds + (qm < 2 ? O_P1T + 32 * qm * STR : O_Q1T + 32 * (qm - 2) * STR);
        f32x16 ax;
        if (qm < 2) {
#pragma unroll
            for (int r = 0; r < 16; ++r) ax[r] = bflo((unsigned)*(const LAS unsigned short*)(lds + O_AT + (32 * qn + crow(r, hi)) * STR + (32 * qm + r32) * 2));
        } else ax = mm_tile<false, true>(lds + O_AAK, lds + O_VT, qn, qm - 2, r32, hi, zero16());
#pragma unroll
        for (int g = 0; g < 4; ++g) { u32x2 w; w.x = cvtpk(ax[4 * g], ax[4 * g + 1]); w.y = cvtpk(ax[4 * g + 2], ax[4 * g + 3]); *(LAS u32x2*)(ximg + r32 * STR + (32 * qn + 8 * g + 4 * hi) * 2) = w; }
        WG_BAR();
        const int pq = wid & 3, pqn = pq >> 1, pqm = pq & 1;
        LAS unsigned char* ximg1 = lds + (qm < 2 ? O_AT + 32 * qm * STR : O_AAK + 32 * (qm - 2) * STR);
#pragma unroll 1
        for (int step = 0; step < 6; ++step) {
            const bool rd = step & 1;
            const LAS unsigned char* xr = rd ? ximg1 : ximg; LAS unsigned char* xw = rd ? ximg : ximg1;
            const LAS unsigned char* Pr = lds + (rd ? O_PT : O_P);
            ax = mm_tile(Pr, xr, qn, 0, r32, hi, ax);
            f32x16 ap;
            if (step < 5 && wid < 4) ap = mm_tile<true, false>(Pr, Pr, pqn, pqm, r32, hi, zero16());
#pragma unroll
            for (int g = 0; g < 4; ++g) { u32x2 w; w.x = cvtpk(ax[4 * g], ax[4 * g + 1]); w.y = cvtpk(ax[4 * g + 2], ax[4 * g + 3]); *(LAS u32x2*)(xw + r32 * STR + (32 * qn + 8 * g + 4 * hi) * 2) = w; }
            if (step < 5 && wid < 4) { LAS unsigned char* pd = lds + (rd ? O_P : O_PT) + (32 * pqm + r32) * STR;
#pragma unroll
                for (int g = 0; g < 4; ++g) { u32x2 w; w.x = cvtpk(ap[4 * g], ap[4 * g + 1]); w.y = cvtpk(ap[4 * g + 2], ap[4 * g + 3]); *(LAS u32x2*)(pd + (32 * pqn + 8 * g + 4 * hi) * 2) = w; } }
            WG_BAR();
        }
    }
    {
        unsigned char* uo = A.AOUT + (size_t)u * UNIT_BYTES;
        const int q = wid & 3, qn = q >> 1, qm = q & 1, mrow = 32 * qm + r32;
        if (wid < 4) {
            f32x16 acc = mm_tile<false, true>(lds + O_P1T, lds + O_BCT, qn, qm, r32, hi, zero16());
            const float gcv = GC[mrow];
            bf16_t* Gp = (bf16_t*)(uo + UO_G) + mrow * 64;
#pragma unroll
            for (int g = 0; g < 4; ++g) { const int n0 = 32 * qn + 8 * g + 4 * hi; float o4[4];
#pragma unroll
                for (int e = 0; e < 4; ++e) o4[e] = acc[4 * g + e] + ((n0 + e == mrow) ? gcv : 0.f);
                u32x2 w; w.x = cvtpk(o4[0], o4[1]); w.y = cvtpk(o4[2], o4[3]); *(u32x2*)(Gp + n0) = w; }
            acc = mm_tile<true, false>(lds + O_BCT, lds + O_Q1T, qn, qm, r32, hi, zero16());
            acc = mm_tile<true, true>(lds + O_KCT, lds + O_VT, qn, qm, r32, hi, acc);
            bf16_t* Hp = (bf16_t*)(uo + UO_HT) + mrow * 64;
#pragma unroll
            for (int g = 0; g < 4; ++g) { u32x2 w; w.x = cvtpk(acc[4 * g], acc[4 * g + 1]); w.y = cvtpk(acc[4 * g + 2], acc[4 * g + 3]); *(u32x2*)(Hp + 32 * qn + 8 * g + 4 * hi) = w; }
        } else {
            f32x16 acc = mm_tile(lds + O_P1T, lds + O_ARB, qn, qm, r32, hi, zero16());
            bf16_t* Yp = (bf16_t*)(uo + UO_Y1) + mrow * 64;
#pragma unroll
            for (int g = 0; g < 4; ++g) { const int n0 = 32 * qn + 8 * g + 4 * hi;
                const u32x2 rt = *(const LAS u32x2*)(lds + O_RT + mrow * STR + n0 * 2);
                u32x2 w; w.x = cvtpk(acc[4 * g] + bflo(rt.x), acc[4 * g + 1] + bfhi(rt.x)); w.y = cvtpk(acc[4 * g + 2] + bflo(rt.y), acc[4 * g + 3] + bfhi(rt.y)); *(u32x2*)(Yp + n0) = w; }
            acc = mm_tile(lds + O_Q1T, lds + O_ARB, qn, qm, r32, hi, zero16());
            acc = mm_tile<true, false>(lds + O_VT, lds + O_ARK, qn, qm, r32, hi, acc);
            bf16_t* Y0p = (bf16_t*)(uo + UO_Y0) + mrow * 64;
#pragma unroll
            for (int g = 0; g < 4; ++g) { u32x2 w; w.x = cvtpk(acc[4 * g], acc[4 * g + 1]); w.y = cvtpk(acc[4 * g + 2], acc[4 * g + 3]); *(u32x2*)(Y0p + 32 * qn + 8 * g + 4 * hi) = w; }
        }
    }
}

__device__ __forceinline__ void state_pass_job(const Args& A, int q, int lane) {
    const int r32 = lane & 31, hi = lane >> 5;
    int bh, half, nch, ubase; const float* init; float* fin;
    if (q < 128) { bh = q >> 1; half = q & 1; nch = 128; ubase = bh * 128; init = nullptr; fin = A.dout + OFF_SRP + (size_t)bh * 4096; }
    else { const int qs = q - 128; bh = qs >> 1; half = qs & 1; nch = 1; ubase = NPROMPT_UNITS + bh; init = A.state_in + (size_t)bh * 4096; fin = A.dout + OFF_SRS + (size_t)bh * 4096; }
    const int i = 32 * half + r32;
    f32x16 X[2];
#pragma unroll
    for (int t2 = 0; t2 < 2; ++t2)
#pragma unroll
        for (int g = 0; g < 4; ++g) {
            f32x4 v = (f32x4){0.f, 0.f, 0.f, 0.f};
            if (init) v = *(const f32x4*)(init + i * 64 + 32 * t2 + 8 * g + 4 * hi);
            X[t2][4 * g] = v[0]; X[t2][4 * g + 1] = v[1]; X[t2][4 * g + 2] = v[2]; X[t2][4 * g + 3] = v[3];
        }
    u32x4 gaA[2][2][2], gaB[2][2][2]; u32x4 htA[2][2], htB[2][2];
#define RW_FETCH(ga, ht, c_) do { \
        const unsigned char* uo_ = A.AOUT + (size_t)(ubase + (c_)) * UNIT_BYTES; \
        const bf16_t* Gp_ = (const bf16_t*)(uo_ + UO_G); const bf16_t* Hp_ = (const bf16_t*)(uo_ + UO_HT); \
        _Pragma("unroll") for (int jt = 0; jt < 2; ++jt) { \
            _Pragma("unroll") for (int t2 = 0; t2 < 2; ++t2) \
                _Pragma("unroll") for (int s = 0; s < 2; ++s) ga[jt][t2][s] = *(const u32x4*)(Gp_ + (32 * jt + r32) * 64 + 8 * (4 * t2 + 2 * s + hi)); \
            _Pragma("unroll") for (int g2 = 0; g2 < 2; ++g2) ht[jt][g2] = *(const u32x4*)(Hp_ + i * 64 + 8 * (4 * jt + 2 * g2 + hi)); \
        } } while (0)
#define RW_STEP(ga, ht, c_, NEXT_) do { \
        bf16_t* Sp = A.S0 + (size_t)(ubase + (c_)) * 4096 + i * 64; \
        bf16x8 xb[2][2]; \
        _Pragma("unroll") for (int t2 = 0; t2 < 2; ++t2) { \
            _Pragma("unroll") for (int g = 0; g < 4; ++g) { u32x2 w; w.x = cvtpk(X[t2][4 * g], X[t2][4 * g + 1]); w.y = cvtpk(X[t2][4 * g + 2], X[t2][4 * g + 3]); *(u32x2*)(Sp + 32 * t2 + 8 * g + 4 * hi) = w; } \
            _Pragma("unroll") for (int s = 0; s < 2; ++s) { u32x4 w; w.x = cvtpk(X[t2][8 * s], X[t2][8 * s + 1]); w.y = cvtpk(X[t2][8 * s + 2], X[t2][8 * s + 3]); w.z = cvtpk(X[t2][8 * s + 4], X[t2][8 * s + 5]); w.w = cvtpk(X[t2][8 * s + 6], X[t2][8 * s + 7]); xb[t2][s] = __builtin_bit_cast(bf16x8, w); } \
        } \
        f32x16 acc[2]; \
        _Pragma("unroll") for (int jt = 0; jt < 2; ++jt) { \
            _Pragma("unroll") for (int g2 = 0; g2 < 2; ++g2) { const u32x4 ck_ = ht[jt][g2]; const auto r0_ = __builtin_amdgcn_permlane32_swap(ck_.x, ck_.z, false, false), r1_ = __builtin_amdgcn_permlane32_swap(ck_.y, ck_.w, false, false); \
                acc[jt][8 * g2] = bflo(r0_[0]); acc[jt][8 * g2 + 1] = bfhi(r0_[0]); acc[jt][8 * g2 + 2] = bflo(r1_[0]); acc[jt][8 * g2 + 3] = bfhi(r1_[0]); \
                acc[jt][8 * g2 + 4] = bflo(r0_[1]); acc[jt][8 * g2 + 5] = bfhi(r0_[1]); acc[jt][8 * g2 + 6] = bflo(r1_[1]); acc[jt][8 * g2 + 7] = bfhi(r1_[1]); } \
            _Pragma("unroll") for (int t2 = 0; t2 < 2; ++t2) \
                _Pragma("unroll") for (int s = 0; s < 2; ++s) { const u32x4 ck_ = ga[jt][t2][s]; const auto r0_ = __builtin_amdgcn_permlane32_swap(ck_.x, ck_.z, false, false), r1_ = __builtin_amdgcn_permlane32_swap(ck_.y, ck_.w, false, false); ga[jt][t2][s] = (u32x4){r0_[0], r1_[0], r0_[1], r1_[1]}; } \
        } \
        _Pragma("unroll") for (int t2 = 0; t2 < 2; ++t2) \
            _Pragma("unroll") for (int s = 0; s < 2; ++s) \
                _Pragma("unroll") for (int jt = 0; jt < 2; ++jt) acc[jt] = __builtin_amdgcn_mfma_f32_32x32x16_bf16(__builtin_bit_cast(bf16x8, ga[jt][t2][s]), xb[t2][s], acc[jt], 0, 0, 0); \
        NEXT_; \
        X[0] = acc[0]; X[1] = acc[1]; } while (0)
    if (q < 128) {
        RW_FETCH(gaA, htA, 0); RW_FETCH(gaB, htB, 1);
#pragma unroll 1
        for (int c = 0; c < 128; c += 2) {
            RW_STEP(gaA, htA, c, RW_FETCH(gaA, htA, min(c + 2, 127)));
            RW_STEP(gaB, htB, c + 1, RW_FETCH(gaB, htB, min(c + 3, 127)));
        }
    } else {
        RW_FETCH(gaA, htA, 0);
        RW_STEP(gaA, htA, 0, (void)0);
    }
#undef RW_FETCH
#undef RW_STEP
#pragma unroll
    for (int t2 = 0; t2 < 2; ++t2)
#pragma unroll
        for (int g = 0; g < 4; ++g) *(f32x4*)(fin + i * 64 + 32 * t2 + 8 * g + 4 * hi) = (f32x4){X[t2][4 * g], X[t2][4 * g + 1], X[t2][4 * g + 2], X[t2][4 * g + 3]};
}

struct ScIn { u32x4 y1a, y1b, s0a, s0b, uva, uvb, upa, upb, gga, ggb; u32x2 y0v[4]; float rk; };
__device__ __forceinline__ void sc_load(const Args& A, int u0, ScIn& in) {
    const int tid = threadIdx.x, lane = tid & 63, wid = __builtin_amdgcn_readfirstlane(tid >> 6), r32 = lane & 31, hi = lane >> 5;
    const int uu = tid >> 8, x = tid & 255, u = unit_of(u0 + uu);
    const unsigned char* uo = A.AOUT + (size_t)u * UNIT_BYTES;
    int b, h, row0; bool sample, firstchunk; unit_decode(u, b, h, row0, sample, firstchunk);
    const int irow = x >> 2, seg = x & 3;
    const bf16_t* y1 = (const bf16_t*)(uo + UO_Y1) + irow * 64 + seg * 16; const bf16_t* s0 = A.S0 + (size_t)u * 4096 + irow * 64 + seg * 16;
    in.y1a = *(const u32x4*)y1; in.y1b = *(const u32x4*)(y1 + 8); in.s0a = *(const u32x4*)s0; in.s0b = *(const u32x4*)(s0 + 8);
    const int q = wid & 3, qn = q >> 1, qm = q & 1, tt = 32 * qm + r32;
    const bf16_t* Y0p = (const bf16_t*)(uo + UO_Y0) + tt * 64;
#pragma unroll
    for (int g = 0; g < 4; ++g) in.y0v[g] = *(const u32x2*)(Y0p + 32 * qn + 8 * g + 4 * hi);
    const int t = x >> 2, ig = x & 3, row = row0 + t, col = h * 64 + 16 * ig;
    in.uva = *(const u32x4*)(A.U + (size_t)row * 3584 + 2048 + col); in.uvb = *(const u32x4*)(A.U + (size_t)row * 3584 + 2048 + col + 8);
    in.upa = prev_row8(A, row, 2048 + col); in.upb = prev_row8(A, row, 2048 + col + 8);
    in.gga = *(const u32x4*)(A.GG + (size_t)row * 1024 + col); in.ggb = *(const u32x4*)(A.GG + (size_t)row * 1024 + col + 8);
    in.rk = A.RK[(size_t)row * 16 + h];
}
__device__ __forceinline__ void stage_c(LAS unsigned char* lds, const Args& A, int u0, const ScIn& in) {
    const int tid = threadIdx.x, lane = tid & 63, wid = __builtin_amdgcn_readfirstlane(tid >> 6), r32 = lane & 31, hi = lane >> 5;
    constexpr int UB = 2 * MAT + 64 * FSTR * 4;
    const int uu = tid >> 8, x = tid & 255, u = unit_of(u0 + uu);
    LAS unsigned char* base = lds + uu * UB;
    int b, h, row0; bool sample, firstchunk; unit_decode(u, b, h, row0, sample, firstchunk);
    const int irow = x >> 2, seg = x & 3;
    const int q = wid & 3, qn = q >> 1, qm = q & 1, tt = 32 * qm + r32;
    const int t = x >> 2, ig = x & 3, i0 = 16 * ig, row = row0 + t, col = h * 64 + i0;
    const bool first = firstchunk && t == 0;
    *(LAS u32x4*)(base + irow * STR + seg * 32) = in.y1a; *(LAS u32x4*)(base + irow * STR + seg * 32 + 16) = in.y1b;
    *(LAS u32x4*)(base + MAT + irow * STR + seg * 32) = in.s0a; *(LAS u32x4*)(base + MAT + irow * STR + seg * 32 + 16) = in.s0b;
    WG_BAR();
    LAS float* Yf = (LAS float*)(base + 2 * MAT);
    {
        f32x16 acc;
#pragma unroll
        for (int g = 0; g < 4; ++g) { acc[4 * g] = bflo(in.y0v[g].x); acc[4 * g + 1] = bfhi(in.y0v[g].x); acc[4 * g + 2] = bflo(in.y0v[g].y); acc[4 * g + 3] = bfhi(in.y0v[g].y); }
        acc = mm_tile(base + MAT, base, qn, qm, r32, hi, acc);
#pragma unroll
        for (int g = 0; g < 4; ++g) *(LAS f32x4*)(Yf + tt * FSTR + 32 * qn + 8 * g + 4 * hi) = (f32x4){acc[4 * g], acc[4 * g + 1], acc[4 * g + 2], acc[4 * g + 3]};
    }
    WG_BAR();
    {
        float y[16]; float s = 0.f;
#pragma unroll
        for (int e4 = 0; e4 < 4; ++e4) { const f32x4 v = *(const LAS f32x4*)(Yf + t * FSTR + i0 + 4 * e4); y[4 * e4] = v[0]; y[4 * e4 + 1] = v[1]; y[4 * e4 + 2] = v[2]; y[4 * e4 + 3] = v[3]; s += (v[0] + v[1]) + (v[2] + v[3]); }
        s += __shfl_xor(s, 1); s += __shfl_xor(s, 2);
        const float mean = s * (1.0f / 64.0f); float q2 = 0.f;
#pragma unroll
        for (int e = 0; e < 16; ++e) { y[e] -= mean; q2 += y[e] * y[e]; }
        q2 += __shfl_xor(q2, 1); q2 += __shfl_xor(q2, 2);
        const float rstd = rsqrtf(q2 * (1.0f / 64.0f) + 64e-5f);
        float v[16], gg[16], lg[16], lb[16], mm_[16];
        ld8(A.lnx_g + col, lg); ld8(A.lnx_g + col + 8, lg + 8); ld8(A.lnx_b + col, lb); ld8(A.lnx_b + col + 8, lb + 8); ld8(A.mu + 2048 + col, mm_); ld8(A.mu + 2048 + col + 8, mm_ + 8);
        { float uu_[16], pp_[16]; unpk8(in.uva, uu_); unpk8(in.uvb, uu_ + 8); unpk8(fix_first8(A, in.upa, 2048 + col, first, sample, b), pp_); unpk8(fix_first8(A, in.upb, 2048 + col + 8, first, sample, b), pp_ + 8);
#pragma unroll
          for (int e = 0; e < 16; ++e) v[e] = uu_[e] + mm_[e] * (pp_[e] - uu_[e]); }
        unpk8(in.gga, gg); unpk8(in.ggb, gg + 8);
        float o[16];
#pragma unroll
        for (int e = 0; e < 16; ++e) o[e] = (y[e] * rstd * lg[e] + lb[e] + in.rk * v[e]) * gg[e];
        *(u32x4*)(A.OB + (size_t)row * 1024 + col) = pk8(o); *(u32x4*)(A.OB + (size_t)row * 1024 + col + 8) = pk8(o + 8);
    }
    WG_BAR();
}
}
constexpr size_t MiB = 1u << 20;
constexpr size_t WS_CTL = 0, CTL_ZERO_BYTES = 1 * MiB;
constexpr int CW_BAR = 4096, CW_QUEUE = 8192;
constexpr size_t CTL_SS1 = 131072, CTL_SS2 = CTL_SS1 + 139264, CTL_SS3 = CTL_SS2 + 139264, CTL_SS4 = CTL_SS3 + 139264;
constexpr size_t WS_W1I = 2 * MiB, WS_W1O = 46 * MiB, WS_WIN = 68 * MiB, WS_WLO = 110 * MiB, WS_WPA = 113 * MiB, WS_WPB = 117 * MiB, WS_WOU = 121 * MiB, WS_W2I = 129 * MiB, WS_W2O = 173 * MiB;
constexpr size_t WS_XB = 196 * MiB;
constexpr size_t WS_OA = WS_XB, WS_OB = WS_XB + 68 * MiB;
constexpr size_t WS_QB = 332 * MiB, WS_KB = 400 * MiB, WS_VB = 464 * MiB;
constexpr size_t WS_MG = 332 * MiB;
constexpr size_t WS_RA = 528 * MiB;
constexpr size_t WS_GA = 936 * MiB, WS_GB = 1072 * MiB;
constexpr size_t WS_U = 1208 * MiB;
constexpr size_t WS_LIN = 828 * MiB;
constexpr size_t WS_LW = 1480 * MiB, WS_AS = 1616 * MiB, WS_GG = 1752 * MiB;
constexpr size_t WS_S0 = 1820 * MiB, WS_RK = 1888 * MiB, WS_XR = 1892 * MiB, WS_END = 2028 * MiB;
constexpr int NWIN = 10752, NLORA = 3072, KLORA = 256, LDLIN = 768;
constexpr int LDS_BYTES = 147456, RING_BYTES = 131072, MISC_OFF = LDS_BYTES - 512;
constexpr int NWAVES = 8;

#define XB_TMO      128
#define XB_XCNT(j)  (256  + 64 * (j))
#define XB_XSUB(j)  (1280 + 64 * (j))
#define XB_XGEN(j)  (2304 + 64 * (j))
#define XB_TOP      3328
#define XB_TOPGEN   3392
#define XCD_BAR_WORDS 3456
#define XB_SPIN_CAP (1u << 18)

__device__ __forceinline__ unsigned xb_ld(unsigned* p)              { return __hip_atomic_load(p, __ATOMIC_RELAXED, __HIP_MEMORY_SCOPE_AGENT); }
__device__ __forceinline__ unsigned xb_add(unsigned* p, unsigned v) { return __hip_atomic_fetch_add(p, v, __ATOMIC_RELAXED, __HIP_MEMORY_SCOPE_AGENT); }
__device__ __forceinline__ unsigned xb_xcc_id() { return (unsigned)__builtin_amdgcn_s_getreg((3 << 11) | 20) & 0xFu; }
#define XB_SPIN(cond, bar) do { unsigned _sp = 0; while (cond) { __builtin_amdgcn_s_sleep(1); \
    if ((++_sp & 255u) == 0u) { if (xb_ld(&(bar)[XB_TMO])) break; if (_sp > XB_SPIN_CAP) { atomicAdd(&(bar)[XB_TMO], 1u); break; } } } } while (0)

struct XcdBarrier {
    unsigned* bar; unsigned x;
    volatile LAS unsigned* st;
};

__device__ __forceinline__ XcdBarrier xcd_barrier_post(unsigned* bar, volatile LAS unsigned* st) {
    XcdBarrier b; b.bar = bar; b.x = xb_xcc_id(); b.st = st;
    if (threadIdx.x == 0) (void)xb_add(&bar[XB_XCNT(b.x)], 1u);
    return b;
}
__device__ __forceinline__ void xcd_barrier_complete(unsigned* bar, unsigned x, unsigned& nloc, unsigned& nx) {
    const unsigned G = gridDim.x * gridDim.y * gridDim.z;
    unsigned sum, cnt, mine, sp = 0u;
    for (;;) {
        sum = 0u; cnt = 0u; mine = 0u;
#pragma unroll
        for (unsigned j = 0; j < 16; ++j) { const unsigned c = xb_ld(&bar[XB_XCNT(j)]); sum += c; cnt += (c > 0u) ? 1u : 0u; mine = (j == x) ? c : mine; }
        if (sum == G) break;
        __builtin_amdgcn_s_sleep(1);
        if ((++sp & 255u) == 0u) { if (xb_ld(&bar[XB_TMO])) break; if (sp > XB_SPIN_CAP) { atomicAdd(&bar[XB_TMO], 1u); break; } }
    }
    nloc = mine > 0u ? mine : 1u; nx = cnt > 0u ? cnt : 1u;
}

__device__ __forceinline__ void xcd_barrier(const XcdBarrier& b) {
    asm volatile("s_waitcnt vmcnt(0)" ::: "memory");
    __syncthreads();
    if (threadIdx.x == 0) {
        unsigned* bar = b.bar;
        __builtin_amdgcn_s_waitcnt(0);
        unsigned nloc = b.st[0], nx = b.st[1];
        if (nloc == 0u) { xcd_barrier_complete(bar, b.x, nloc, nx); b.st[0] = nloc; b.st[1] = nx; }
        const unsigned old = xb_add(&bar[XB_XSUB(b.x)], 1u);
        const unsigned gen = old / nloc;
        if (old + 1u == (gen + 1u) * nloc) {
            __builtin_amdgcn_fence(__ATOMIC_RELEASE, "agent");
            asm volatile("s_waitcnt vmcnt(0)" ::: "memory");
            const unsigned og = xb_add(&bar[XB_TOP], 1u);
            const unsigned tg = og / nx;
            if (og + 1u == (tg + 1u) * nx) xb_add(&bar[XB_TOPGEN], 1u);
            else XB_SPIN(xb_ld(&bar[XB_TOPGEN]) == tg, bar);
            __builtin_amdgcn_fence(__ATOMIC_ACQUIRE, "agent");
            xb_add(&bar[XB_XGEN(b.x)], 1u);
            asm volatile("s_waitcnt vmcnt(0)" ::: "memory");
        } else {
            XB_SPIN(xb_ld(&bar[XB_XGEN(b.x)]) == gen, bar);
            __builtin_amdgcn_fence(__ATOMIC_ACQUIRE, "agent");
            asm volatile("s_waitcnt vmcnt(0)" ::: "memory");
        }
    }
    __syncthreads();
}

struct KArgs { const float* in[34]; float* out; unsigned char* ws; int ph_lo, ph_hi; };
constexpr int NPHASE = 15;

__device__ __forceinline__ float wave_sum(float v) {
#pragma unroll
    for (int o = 1; o < 64; o <<= 1) v += __shfl_xor(v, o);
    return v;
}
template <bool GAIN> __device__ __forceinline__ void transpose_item(const float* W, int K, int N, bf16_t* WT, const float* gain, int k0, int n0, int dst_row0, LAS unsigned char* scr, int lane) {
    asm volatile("" : "+v"(lane));
    const int c4 = lane & 15, kr = lane >> 4;
#pragma unroll
    for (int h8 = 0; h8 < 2; ++h8) {
        f32x4 v[8]; float g[8];
#pragma unroll
        for (int i = 0; i < 8; ++i) { const int k = 4 * (8 * h8 + i) + kr; v[i] = *(const f32x4*)(W + (size_t)(k0 + k) * N + n0 + 4 * c4); if (GAIN) g[i] = gain[k0 + k]; }
#pragma unroll
        for (int i = 0; i < 8; ++i) { const int k = 4 * (8 * h8 + i) + kr; f32x4 x = v[i]; if (GAIN) x = x * g[i]; u32x2 w; w.x = cvtpk(x[0], x[1]); w.y = cvtpk(x[2], x[3]); *(LAS u32x2*)(scr + k * 144 + c4 * 8) = w; }
    }
    asm volatile("s_waitcnt lgkmcnt(0)" ::: "memory");
    const int gq = lane >> 4, i16 = lane & 15;
#pragma unroll
    for (int j = 0; j < 8; ++j) {
        const int kc = 4 * (j & 1) + gq, nb = j >> 1;
        const LAS unsigned char* p = scr + (8 * kc + (i16 >> 2)) * 144 + (16 * nb + 4 * (i16 & 3)) * 2;
        const s16x4 lo = vtr(p), hi = vtr(p + 4 * 144);
        u32x4 o; o.x = (unsigned)(unsigned short)lo[0] | ((unsigned)(unsigned short)lo[1] << 16); o.y = (unsigned)(unsigned short)lo[2] | ((unsigned)(unsigned short)lo[3] << 16);
        o.z = (unsigned)(unsigned short)hi[0] | ((unsigned)(unsigned short)hi[1] << 16); o.w = (unsigned)(unsigned short)hi[2] | ((unsigned)(unsigned short)hi[3] << 16);
        *(u32x4*)(WT + (size_t)(dst_row0 + 16 * nb + i16) * K + k0 + 8 * kc) = o;
    }
    asm volatile("s_waitcnt lgkmcnt(0)" ::: "memory");
}
template <bool GAIN> __device__ __forceinline__ void transpose_matrix(const float* W, int K, int N, bf16_t* WT, const float* gain, int map, LAS unsigned char* scr, int gw, int ngw, int lane) {
    const int nblk = N / 64, nitems = (K / 64) * nblk;
    for (int it = gw; it < nitems; it += ngw) {
        const int kb = it / nblk, nb = it % nblk, n0 = 64 * nb;
        int d0 = n0;
        if (map == 1) d0 = (n0 < FFD) ? 256 * (n0 / 128) + (n0 % 128) : 256 * ((n0 - FFD) / 128) + 128 + ((n0 - FFD) % 128);
        else if (map == 2) d0 = (n0 < 6592) ? n0 : n0 + 64;
        transpose_item<GAIN>(W, K, N, WT, gain, 64 * kb, n0, d0, scr, lane);
    }
}

__global__ void __launch_bounds__(NWAVES * 64, 2) fwd_kernel(KArgs args) {
    extern __shared__ __attribute__((aligned(16))) unsigned char lds_raw[];
    LAS unsigned char* lds = (LAS unsigned char*)lds_raw;
    volatile LAS unsigned* MISC = (volatile LAS unsigned*)(lds + MISC_OFF);
    const int tid = threadIdx.x, lane = tid & 63, wave = __builtin_amdgcn_readfirstlane(tid >> 6);
    const int G = gridDim.x; const int bx = blockIdx.x; const int vcu = (G % 8 == 0) ? (bx % 8) * (G / 8) + bx / 8 : bx;
    unsigned char* ws = args.ws; float* dout = args.out;
    unsigned* ctl = (unsigned*)(ws + WS_CTL);
    for (int u = tid; u < (LDS_BYTES - RING_BYTES) / 4; u += NWAVES * 64) ((LAS unsigned*)(lds + RING_BYTES))[u] = 0u;
    __syncthreads();
    const int lo = args.ph_lo, hi_ = args.ph_hi;
    const bool use_bar = (hi_ - lo) > 1;
    XcdBarrier bar; bar.bar = ctl + CW_BAR; bar.x = 0; bar.st = nullptr;
    if (use_bar) bar = xcd_barrier_post(ctl + CW_BAR, MISC + 8);
#ifndef ONLY_PHASE
#define ONLY_PHASE -1
#endif
#define IN(k) ((ONLY_PHASE < 0 || ONLY_PHASE == (k)) && lo <= (k) && (k) < hi_)
#define SEAM(k) do { if (IN(k) && IN((k) + 1)) xcd_barrier(bar); } while (0)

    const float* x_prompt = args.in[0]; const float* x_sample = args.in[1];
    float* ss1 = (float*)(ws + CTL_SS1); float* ss2 = (float*)(ws + CTL_SS2); float* ss3 = (float*)(ws + CTL_SS3); float* ss4 = (float*)(ws + CTL_SS4);
    bf16_t* W1I = (bf16_t*)(ws + WS_W1I); bf16_t* W1O = (bf16_t*)(ws + WS_W1O); bf16_t* WIN = (bf16_t*)(ws + WS_WIN); bf16_t* WLO = (bf16_t*)(ws + WS_WLO);
    bf16_t* WPA = (bf16_t*)(ws + WS_WPA); bf16_t* WPB = (bf16_t*)(ws + WS_WPB); bf16_t* WOU = (bf16_t*)(ws + WS_WOU); bf16_t* W2I = (bf16_t*)(ws + WS_W2I); bf16_t* W2O = (bf16_t*)(ws + WS_W2O);
    bf16_t* XR = (bf16_t*)(ws + WS_XR); bf16_t* XB = (bf16_t*)(ws + WS_XB); bf16_t* OA = (bf16_t*)(ws + WS_OA); bf16_t* OB = (bf16_t*)(ws + WS_OB);
    bf16_t* QB = (bf16_t*)(ws + WS_QB); bf16_t* KB = (bf16_t*)(ws + WS_KB); bf16_t* VB = (bf16_t*)(ws + WS_VB); bf16_t* MG = (bf16_t*)(ws + WS_MG);
    bf16_t* ACT = (bf16_t*)(ws + WS_RA); bf16_t* GA = (bf16_t*)(ws + WS_GA); bf16_t* GB = (bf16_t*)(ws + WS_GB); bf16_t* U = (bf16_t*)(ws + WS_U); bf16_t* LIN = (bf16_t*)(ws + WS_LIN);
    bf16_t* LW = (bf16_t*)(ws + WS_LW); bf16_t* AS = (bf16_t*)(ws + WS_AS); bf16_t* GG = (bf16_t*)(ws + WS_GG);
    float* X = dout + OFF_YP;

    if (IN(0)) {
        LAS unsigned char* scr = lds + wave * 16384;
        const int gw = vcu * NWAVES + wave, ngw = G * NWAVES;
        transpose_matrix<true>(args.in[7], DM, 2 * FFD, W1I, args.in[6], 1, scr, gw, ngw, lane);
        const int gt = vcu * NWAVES * 64 + tid, ngt = G * NWAVES * 64;
        for (int i = gt; i < 64 * 2048 / 8; i += ngt) *(u32x4*)(WIN + (size_t)6592 * 2048 + (size_t)i * 8) = (u32x4){0u, 0u, 0u, 0u};
        {
            const float* w2 = args.in[18]; const float* a2 = args.in[20]; const float* g2 = args.in[21];
            for (int it = gt; it < NLORA * (KLORA / 8); it += ngt) {
                const int n = it % NLORA, k0 = (it / NLORA) * 8; float o[8];
#pragma unroll
                for (int e = 0; e < 8; ++e) { const int k = k0 + e; float v = 0.f;
                    if (n < 1024) { if (k < 96) v = w2[(size_t)k * 1024 + n]; }
                    else if (n < 2048) { if (k < 96) v = a2[(size_t)k * 1024 + (n - 1024)]; }
                    else v = g2[(size_t)k * 1024 + (n - 2048)];
                    o[e] = v; }
                *(u32x4*)(WLO + (size_t)n * KLORA + k0) = pk8(o);
            }
        }
        for (int m = gw; m < MROWS; m += 2 * ngw) {
            const int m2 = m + ngw; const bool has2 = m2 < MROWS; const int mb = has2 ? m2 : m;
            const float* xa = (m < MP) ? x_prompt + (size_t)m * DM : x_sample + (size_t)(m - MP) * DM;
            const float* xc = (mb < MP) ? x_prompt + (size_t)mb * DM : x_sample + (size_t)(mb - MP) * DM;
            f32x4 va[8], vb[8];
#pragma unroll
            for (int j = 0; j < 8; ++j) { va[j] = *(const f32x4*)(xa + 4 * lane + 256 * j); vb[j] = *(const f32x4*)(xc + 4 * lane + 256 * j); }
            float sa = 0.f, sb = 0.f;
#pragma unroll
            for (int j = 0; j < 8; ++j) { const f32x4 v = va[j]; sa += (v[0] * v[0] + v[1] * v[1]) + (v[2] * v[2] + v[3] * v[3]);
                u32x2 w; w.x = cvtpk(v[0], v[1]); w.y = cvtpk(v[2], v[3]); *(u32x2*)(XB + (size_t)m * DM + 4 * lane + 256 * j) = w; }
            sa = wave_sum(sa);
            if (lane == 0) ss1[m] = sa;
            if (has2) {
#pragma unroll
                for (int j = 0; j < 8; ++j) { const f32x4 v = vb[j]; sb += (v[0] * v[0] + v[1] * v[1]) + (v[2] * v[2] + v[3] * v[3]);
                    u32x2 w; w.x = cvtpk(v[0], v[1]); w.y = cvtpk(v[2], v[3]); *(u32x2*)(XB + (size_t)m2 * DM + 4 * lane + 256 * j) = w; }
                sb = wave_sum(sb);
                if (lane == 0) ss1[m2] = sb;
            }
        }
    }
    SEAM(0);
#define FILLER(nunits_, ...) do { const int nlong_ = (nunits_) % G; if (nlong_ != 0 && bx >= nlong_) { const int fgw = (bx - nlong_) * NWAVES + wave, fngw = (G - nlong_) * NWAVES; LAS unsigned char* fscr = lds + wave * 16384; __VA_ARGS__ __syncthreads(); } } while (0)
    if (IN(1)) FILLER((MROWS / 256) * (2 * FFD / 256), transpose_matrix<false>(args.in[8], FFD, DM, W1O, nullptr, 0, fscr, fgw, fngw, lane););
    if (IN(1)) { pg8::Gemm g{XB, W1I, MROWS, 2 * FFD, DM}; pg8::StaticOrder S; S.init(MROWS, 2 * FFD, G, bx); pg8::EpiSwiGLU E{ACT, ss1};
        pg8::gemm_phase<pg8::EpiSwiGLU, pg8::StaticOrder, true, true>(lds, g, S, E); }
    SEAM(1);
    if (IN(2)) { LAS unsigned char* fscr = lds + wave * 16384; transpose_matrix<true>(args.in[10], DM, 10688, WIN, args.in[9], 2, fscr, vcu * NWAVES + wave, G * NWAVES, lane); __syncthreads(); }
    if (IN(2)) { pg8::Gemm g{ACT, W1O, MROWS, DM, FFD}; pg8::PanelOrder S{bx, 0}; pg8::EpiResid<true, true> E{nullptr, nullptr, XB, nullptr, XR, ss2, 0.5f};
        pg8::gemm_phase<pg8::EpiResid<true, true>, pg8::PanelOrder, true, true>(lds, g, S, E); }
    if (IN(2)) xcd_barrier(bar);
    if (IN(2)) {
        if (bx < 64) { pg8::Gemm g{ACT, W1O, MROWS, DM, FFD}; pg8::PanelOrder S{bx, 1}; pg8::EpiResid<true, true> E{nullptr, nullptr, XB, nullptr, XR, ss2, 0.5f};
            pg8::gemm_phase<pg8::EpiResid<true, true>, pg8::PanelOrder, true, true>(lds, g, S, E); }
        else { pg8::Gemm g{XR, WIN, MROWS, NWIN, DM}; pg8::RangeOrder S{MROWS / 256, NWIN / 256, (MROWS / 256) * (NWIN / 256) / 8, bx & 7, (bx - 64) >> 3, 24, 0, 72}; pg8::EpiWin E{ss2, QB, KB, VB, dout, U, GA, GB};
            pg8::gemm_phase<pg8::EpiWin, pg8::RangeOrder, true, true>(lds, g, S, E); }
    }
    SEAM(2);
    if (IN(3)) { pg8::Gemm g{XR, WIN, MROWS, NWIN, DM}; pg8::RangeOrder S{MROWS / 256, NWIN / 256, (MROWS / 256) * (NWIN / 256) / 8, bx & 7, bx >> 3, 32, 72, 642}; pg8::EpiWin E{ss2, QB, KB, VB, dout, U, GA, GB};
        pg8::gemm_phase<pg8::EpiWin, pg8::RangeOrder, true, true>(lds, g, S, E); }
    if (IN(3)) { if (bx >= 16) { const int fgw = (bx - 16) * NWAVES + wave, fngw = (G - 16) * NWAVES; LAS unsigned char* fscr = lds + wave * 16384;
        transpose_matrix<false>(args.in[27], 1024, DM, WPA, nullptr, 0, fscr, fgw, fngw, lane); transpose_matrix<false>(args.in[28], 1024, DM, WPB, nullptr, 0, fscr, fgw, fngw, lane); transpose_matrix<false>(args.in[29], DM, DM, WOU, nullptr, 0, fscr, fgw, fngw, lane); __syncthreads(); } }
    SEAM(3);
    rw::Args RA;
    RA.U = U; RA.LW = LW; RA.AS = AS; RA.GG = GG; RA.mu = args.in[16]; RA.shift_in = args.in[5]; RA.state_in = args.in[4];
    RA.k_k = args.in[22]; RA.k_a = args.in[23]; RA.r_k = args.in[24]; RA.lnx_g = args.in[25]; RA.lnx_b = args.in[26];
    RA.AOUT = ws + WS_RA; RA.S0 = (bf16_t*)(ws + WS_S0); RA.RK = (float*)(ws + WS_RK); RA.OB = OB; RA.dout = dout;
    if (IN(4)) {
        for (int blk = vcu; blk < MROWS / 16; blk += G) {
            const int row = blk * 16 + (tid >> 5);
            const bool sample = row >= MP; const int t = sample ? ((row - MP) & 63) : (row & 8191), b = sample ? ((row - MP) >> 6) : (row >> 13);
#pragma unroll
            for (int k3 = 0; k3 < 3; ++k3) {
                const int cg = (tid & 31) + 32 * k3;
                float o[8];
                const int src = (cg < 12) ? cg : (cg >= 32 && cg < 44) ? cg - 20 : (cg >= 64) ? cg - 40 : -1;
                if (src >= 0) {
                    rw::shifted8(RA, row, 3072 + 8 * src, t == 0, sample, b, o);
#pragma unroll
                    for (int e = 0; e < 8; ++e) { if (cg < 12) { const float ex = __expf(2.0f * o[e]); o[e] = 1.0f - 2.0f * __builtin_amdgcn_rcpf(ex + 1.0f); } else if (cg >= 64) o[e] = pg8::sigm(o[e]); }
                } else {
#pragma unroll
                    for (int e = 0; e < 8; ++e) o[e] = 0.f; }
                *(u32x4*)(LIN + (size_t)(cg >> 5) * ((size_t)MROWS * 256) + (size_t)row * 256 + 8 * (cg & 31)) = pk8(o);
            }
        }
    }
    SEAM(4);
    if (IN(5)) { pg8::Gemm g{LIN, WLO, MROWS, NLORA, KLORA}; pg8::LoraOrder S; S.so.init(MROWS, NLORA, G, bx); pg8::EpiLora E{args.in[17], args.in[19], LW, AS, GG};
        pg8::gemm_phase<pg8::EpiLora, pg8::LoraOrder, true, true>(lds, g, S, E); }
    SEAM(5);
    if (IN(6)) {
        {
            LAS float* ptab = (LAS float*)(lds + rw::PT_OFF);
            for (int i = tid; i < 16 * 6 * 16; i += NWAVES * 64) { const int hh = i / 96, r = i % 96, arr = r >> 4, j4 = (r & 15) * 4;
                const float* src = (arr == 0 ? RA.k_k : arr == 1 ? RA.k_a : arr == 2 ? RA.r_k : RA.mu + (arr - 3) * 1024) + hh * 64 + j4;
                *(LAS f32x4*)(ptab + hh * 384 + arr * 64 + j4) = *(const f32x4*)src; }
            __syncthreads(); }
        rw::PrepIn pin; if (vcu < rw::NUNITS) rw::prep_load(RA, rw::unit_of(vcu), pin); for (int w = vcu; w < rw::NUNITS; w += G) rw::stage_a(lds, RA, rw::unit_of(w), pin, (w + G < rw::NUNITS) ? rw::unit_of(w + G) : -1); }
    SEAM(6);
    if (IN(7)) {
        float lam;
        { const float a = wave_sum(args.in[11][lane] * args.in[12][lane]), b2 = wave_sum(args.in[13][lane] * args.in[14][lane]); lam = __expf(a) - __expf(b2) + 0.2f; }
        unsigned* qhead = ctl + CW_QUEUE;
        for (;;) {
            if (tid == 0) MISC[16] = __hip_atomic_fetch_add(qhead, 1u, __ATOMIC_RELAXED, __HIP_MEMORY_SCOPE_AGENT);
            __syncthreads();
            const int it = (int)MISC[16];
            __syncthreads();
            if (it >= 2464) break;
            if (it < 32) { if (wave < 4) rw::state_pass_job(RA, it * 4 + wave, lane); }
            else if (it < 160) { rw::state_pass_job(RA, 128 + (it - 32) * 8 + wave, lane); }
            else if (it < 2208) {
                const int j = it - 160, qb = 63 - (j >> 5), bh = j & 31, b = bh >> 3, h = bh & 7;
                att::Src S; S.k = KB + (size_t)b * 8192 * 1024 + h * 128; S.v = VB + (size_t)b * 8192 * 1024 + h * 128; S.kn = nullptr; S.vn = nullptr;
                const size_t r0 = (size_t)b * 8192 + (size_t)qb * 128;
                att::unit<false>(lds, QB + r0 * 1024 + h * 128, S, 2 * qb + 1, 2 * qb + 2, OA + r0 * 1024 + h * 128, lam, args.in[15]);
            } else {
                const int j = it - 2208, b = j >> 3, h = j & 7;
                att::Src S; S.k = args.in[2] + (size_t)b * 4096 * 1024 + h * 128; S.v = args.in[3] + (size_t)b * 4096 * 1024 + h * 128;
                S.kn = dout + OFF_KS + (size_t)b * 64 * 1024 + h * 128; S.vn = dout + OFF_VS + (size_t)b * 64 * 1024 + h * 128;
                att::unit<true>(lds, QB + (size_t)(MP + b * 64) * 1024 + h * 128, S, 65, 0, OA + (size_t)(MP + b * 64) * 1024 + h * 128, lam, args.in[15]);
            }
        }
    }
    SEAM(7);
    if (IN(8)) { rw::ScIn sa, sb; constexpr int NPAIR = rw::NUNITS / 2; if (vcu < NPAIR) rw::sc_load(RA, 2 * vcu, sa);
#pragma unroll 1
        for (int p = vcu; p < NPAIR; p += 2 * G) {
            if (p + G < NPAIR) rw::sc_load(RA, 2 * (p + G), sb);
            rw::stage_c(lds, RA, 2 * p, sa);
            if (p + G < NPAIR) { if (p + 2 * G < NPAIR) rw::sc_load(RA, 2 * (p + 2 * G), sa); rw::stage_c(lds, RA, 2 * (p + G), sb); } } }
    SEAM(8);
    if (IN(10)) FILLER((MROWS / 256) * (DM / 256), transpose_matrix<false>(args.in[32], FFD, DM, W2O, nullptr, 0, fscr, fgw, fngw, lane););
    if (IN(10)) {
        { pg8::Gemm g{OA, WPA, MROWS, DM, 1024}; pg8::StaticOrder S; S.init(MROWS, DM, G, bx); pg8::EpiProj<false> E{GA, MG}; pg8::gemm_phase<pg8::EpiProj<false>, pg8::StaticOrder, true, true>(lds, g, S, E); }
        __syncthreads();
        { pg8::Gemm g{OB, WPB, MROWS, DM, 1024}; pg8::StaticOrder S; S.init(MROWS, DM, G, bx); pg8::EpiProj<true> E{GB, MG}; pg8::gemm_phase<pg8::EpiProj<true>, pg8::StaticOrder, true, true>(lds, g, S, E); }
    }
    SEAM(10);
    if (IN(11)) FILLER((MROWS / 256) * (DM / 256), transpose_matrix<true>(args.in[31], DM, 2 * FFD, W2I, args.in[30], 1, fscr, fgw, fngw, lane););
    if (IN(11)) { pg8::Gemm g{MG, WOU, MROWS, DM, DM}; pg8::StaticOrder S; S.init(MROWS, DM, G, bx); pg8::EpiResid<true, true> E{nullptr, nullptr, XR, nullptr, XB, ss3, 1.0f};
        pg8::gemm_phase<pg8::EpiResid<true, true>, pg8::StaticOrder, true, true>(lds, g, S, E); }
    SEAM(11);
    if (IN(12)) { pg8::Gemm g{XB, W2I, MROWS, 2 * FFD, DM}; pg8::StaticOrder S; S.init(MROWS, 2 * FFD, G, bx); pg8::EpiSwiGLU E{ACT, ss3};
        pg8::gemm_phase<pg8::EpiSwiGLU, pg8::StaticOrder, true, true>(lds, g, S, E); }
    SEAM(12);
    if (IN(13)) { pg8::Gemm g{ACT, W2O, MROWS, DM, FFD}; pg8::PanelOrder S{bx, 0}; pg8::EpiResid<true, true> E{nullptr, nullptr, XB, nullptr, XR, ss4, 0.5f};
        pg8::gemm_phase<pg8::EpiResid<true, true>, pg8::PanelOrder, true, true>(lds, g, S, E); }
    SEAM(13);
#define FINAL_NORM_ROW(m_) do { float* yr = X + (size_t)(m_) * DM; const bf16_t* xr = XR + (size_t)(m_) * DM; const float rs = rsqrtf(ss4[m_] * (1.0f / 2048.0f) + 1e-6f); \
        _Pragma("unroll") for (int j = 0; j < 4; ++j) { const u32x4 w = *(const u32x4*)(xr + 8 * lane + 512 * j); float v[8]; unpk8(w, v); \
            const f32x4 g0 = *(const f32x4*)(fg + 8 * lane + 512 * j), g1 = *(const f32x4*)(fg + 8 * lane + 512 * j + 4); \
            *(f32x4*)(yr + 8 * lane + 512 * j) = (f32x4){v[0] * rs * g0[0], v[1] * rs * g0[1], v[2] * rs * g0[2], v[3] * rs * g0[3]}; \
            *(f32x4*)(yr + 8 * lane + 512 * j + 4) = (f32x4){v[4] * rs * g1[0], v[5] * rs * g1[1], v[6] * rs * g1[2], v[7] * rs * g1[3]}; } } while (0)
    if (IN(14)) {
        const float* fg = args.in[33];
        if (bx < 64) { pg8::Gemm g{ACT, W2O, MROWS, DM, FFD}; pg8::PanelOrder S{bx, 1}; pg8::EpiResid<true, true> E{nullptr, nullptr, XB, nullptr, XR, ss4, 0.5f};
            pg8::gemm_phase<pg8::EpiResid<true, true>, pg8::PanelOrder, true, true>(lds, g, S, E); }
        else { for (int m = (bx - 64) * NWAVES + wave; m < MP; m += (G - 64) * NWAVES) FINAL_NORM_ROW(m); }
        xcd_barrier(bar);
        for (int m = MP + bx * NWAVES + wave; m < MROWS; m += G * NWAVES) FINAL_NORM_ROW(m);
    }
#undef FINAL_NORM_ROW
#undef IN
#undef SEAM
}

extern "C" void kernel_launch(void* const* d_in, const int* in_sizes, int n_in, void* d_out, int out_size, void* d_ws, size_t ws_size, hipStream_t stream) {
    static int grid = 0;
    if (grid == 0) {
        if (n_in != 34 || (size_t)out_size != OUT_TOTAL || ws_size < WS_END) { fprintf(stderr, "kernel_launch: unexpected shapes: n_in %d out %d ws %zu\n", n_in, out_size, ws_size); grid = -1; return; }
        int dev = 0, cus = 0;
        if (hipGetDevice(&dev) != hipSuccess || hipDeviceGetAttribute(&cus, hipDeviceAttributeMultiprocessorCount, dev) != hipSuccess) { grid = -1; return; }
        if (hipFuncSetAttribute((const void*)fwd_kernel, hipFuncAttributeMaxDynamicSharedMemorySize, LDS_BYTES) != hipSuccess) { fprintf(stderr, "kernel_launch: hipFuncSetAttribute failed\n"); grid = -1; return; }
        int per_cu = 0;
        if (hipOccupancyMaxActiveBlocksPerMultiprocessor(&per_cu, (const void*)fwd_kernel, NWAVES * 64, LDS_BYTES) != hipSuccess || per_cu < 1) fprintf(stderr, "kernel_launch: occupancy query says %d\n", per_cu);
        (void)hipGetLastError();
        grid = cus;
    }
    if (grid < 0) return;
    (void)hipMemsetAsync((char*)d_ws + WS_CTL, 0, CTL_ZERO_BYTES, stream);
    KArgs a{};
    for (int i = 0; i < 34; ++i) a.in[i] = (const float*)d_in[i];
    a.out = (float*)d_out; a.ws = (unsigned char*)d_ws;
#ifndef ONE_LAUNCH
#define ONE_LAUNCH 1
#endif
    if (ONE_LAUNCH) { a.ph_lo = 0; a.ph_hi = NPHASE; hipLaunchKernelGGL(fwd_kernel, dim3(grid), dim3(NWAVES * 64), LDS_BYTES, stream, a); }
#ifndef LAST_PHASE
#define LAST_PHASE (NPHASE - 1)
#endif
    else for (int p = 0; p <= LAST_PHASE; ++p) { a.ph_lo = p; a.ph_hi = p + 1; hipLaunchKernelGGL(fwd_kernel, dim3(grid), dim3(NWAVES * 64), LDS_BYTES, stream, a); }
}
```

```cpp
#include <hip/hip_runtime.h>
#include <hip/hip_bf16.h>
#include <cstdio>
#include <cstdint>
constexpr int MROWS = 34816, MP = 32768, DM = 2048, FFD = 5632;
constexpr size_t OFF_YP = 0, OFF_YS = 67108864, OFF_KP = 71303168, OFF_VP = 104857600, OFF_SRP = 138412032, OFF_SHP = 138674176,
                 OFF_KS = 138688256, OFF_VS = 140785408, OFF_SRS = 142882560, OFF_SHS = 144979712, OUT_TOTAL = 145092352;
constexpr float QSCALE = 0.125f * 1.4426950408889634f;
namespace pg8 {
#define PG8_LAS __attribute__((address_space(3)))
typedef unsigned short bf16_t;
typedef short bf16x8 __attribute__((ext_vector_type(8)));
typedef float f32x4 __attribute__((ext_vector_type(4)));
typedef unsigned u32x4 __attribute__((ext_vector_type(4)));
constexpr int BM = 256, BK = 64, HALF = 128, HTB = HALF * BK * 2  , STAGE_BYTES = 8 * HTB, NXCD = 8, WGM = 8;

__host__ __device__ __forceinline__ int lds_byte(int r, int c) { const int st = (r >> 4) * 2 + (c >> 5), rr = r & 15, cc = c & 31, ob = rr * 64 + cc * 2; return st * 1024 + (ob ^ (((ob >> 9) & 1) << 5)); }
__host__ __device__ __forceinline__ void stage_rc(int b, int& R, int& C) { const int st = b / 1024, sb = b % 1024, swz = sb ^ (((sb >> 9) & 1) << 5); R = (st >> 1) * 16 + swz / 64; C = (st & 1) * 32 + (swz % 64) / 2; }
__host__ __device__ __forceinline__ int perm32(int rho) { const int n = rho >> 4, i = rho & 15; return 8 * (i >> 2) + 4 * n + (i & 3); }

struct Unit { int pm, pn, oa; };
struct Gemm { const bf16_t* A; const bf16_t* Bt; int M, N, K, lda; };

struct StaticOrder {
    int nM, nN, nwg, G, c;
    __host__ __device__ void init(int M, int N, int G_, int c_) { nM = M / BM; nN = N / BM; nwg = nM * nN; G = G_; c = c_; }
    __host__ __device__ bool next(int i, Unit& u) const {
        const long L = (long)i * G + c; if (L >= nwg) return false;
        int wgid = (int)L; { const int q = nwg / NXCD, r = nwg % NXCD, xcd = wgid % NXCD, off = wgid / NXCD; wgid = (xcd < r ? xcd * (q + 1) : r * (q + 1) + (xcd - r) * q) + off; }
        const int nig = WGM * nN, gid = wgid / nig, fm = gid * WGM, gsz = (nM - fm) < WGM ? (nM - fm) : WGM;
        u.pm = fm + ((wgid % nig) % gsz); u.pn = (wgid % nig) / gsz; u.oa = 0; return true;
    }
    __device__ __forceinline__ void a_ready(const Unit&) const {}
    __device__ __forceinline__ void done(const Unit&) const {}
};

typedef float f32x2_cv __attribute__((ext_vector_type(2))); typedef __bf16 bf16x2_cv __attribute__((ext_vector_type(2)));
__device__ __forceinline__ unsigned cvt_pk_bf16(float lo, float hi) { f32x2_cv v = {lo, hi}; bf16x2_cv b = __builtin_convertvector(v, bf16x2_cv); return __builtin_bit_cast(unsigned, b); }
typedef unsigned u32x2 __attribute__((ext_vector_type(2)));
__device__ __forceinline__ float bf_lo(unsigned w) { return __uint_as_float(w << 16); }
__device__ __forceinline__ float bf_hi(unsigned w) { return __uint_as_float(w & 0xffff0000u); }
__device__ __forceinline__ float sigm(float x) { return __builtin_amdgcn_rcpf(1.0f + __expf(-x)); }
__device__ __forceinline__ u32x4 pack8(const float* o) { u32x4 w; w.x = cvt_pk_bf16(o[0], o[1]); w.y = cvt_pk_bf16(o[2], o[3]); w.z = cvt_pk_bf16(o[4], o[5]); w.w = cvt_pk_bf16(o[6], o[7]); return w; }

struct EpiSwiGLU {
    static constexpr bool PERM = true, AFTER_DRAIN = false;
    bf16_t* O; const float* ss;
    __device__ __forceinline__ void operator()(const f32x4 (&acc)[2][2][4][2], const Unit& u, int wr, int wc, int fr, int fq) const {
        const int row0 = u.pm * BM + wr * 64 + fr, col0 = u.pn * HALF + wc * 32 + 8 * fq;
        float rsv[8];
#pragma unroll
        for (int g = 0; g < 8; ++g) rsv[g] = ss[row0 + (g >> 2) * HALF + (g & 3) * 16];
        asm volatile("" : "+v"(rsv[0]), "+v"(rsv[1]), "+v"(rsv[2]), "+v"(rsv[3]), "+v"(rsv[4]), "+v"(rsv[5]), "+v"(rsv[6]), "+v"(rsv[7]));
#pragma unroll
        for (int ai = 0; ai < 2; ++ai)
#pragma unroll
            for (int m = 0; m < 4; ++m) {
                const int row = row0 + ai * HALF + m * 16;
                const float rs = rsqrtf(rsv[ai * 4 + m] * (1.0f / 2048.0f) + 1e-6f);
                float o[8];
#pragma unroll
                for (int n = 0; n < 2; ++n)
#pragma unroll
                    for (int e = 0; e < 4; ++e) { const float g = acc[ai][0][m][n][e] * rs, up = acc[ai][1][m][n][e] * rs; o[4 * n + e] = g * sigm(g) * up; }
                *(u32x4*)(O + (size_t)row * FFD + col0) = pack8(o);
            }
    }
};
template <bool IN_BF16, bool OUT_BF16> struct EpiResid {
    static constexpr bool PERM = true, AFTER_DRAIN = false;
    const float* xp; const float* xs; const bf16_t* xin_b; float* xo; bf16_t* xb; float* ss; float scale;
    __device__ __forceinline__ void operator()(const f32x4 (&acc)[2][2][4][2], const Unit& u, int wr, int wc, int fr, int fq) const {
        const int row0 = u.pm * BM + wr * 64 + fr, col0 = u.pn * BM + wc * 32 + 8 * fq;
        f32x4 xi[8][4]; u32x4 xw[8][2];
#define RES_LOAD(g) do { const int row_ = row0 + ((g) >> 2) * HALF + ((g) & 3) * 16; \
        if (IN_BF16) { const bf16_t* xin_ = xin_b + (size_t)row_ * DM; xw[g][0] = *(const u32x4*)(xin_ + col0); xw[g][1] = *(const u32x4*)(xin_ + col0 + HALF); } \
        else { const float* xin_ = (row_ < MP) ? xp + (size_t)row_ * DM : xs + (size_t)(row_ - MP) * DM; \
               xi[g][0] = *(const f32x4*)(xin_ + col0); xi[g][1] = *(const f32x4*)(xin_ + col0 + 4); xi[g][2] = *(const f32x4*)(xin_ + col0 + HALF); xi[g][3] = *(const f32x4*)(xin_ + col0 + HALF + 4); } } while (0)
        RES_LOAD(0); RES_LOAD(1);
#pragma unroll
        for (int g = 0; g < 8; ++g) {
            const int ai = g >> 2, m = g & 3, row = row0 + ai * HALF + m * 16;
            float sq = 0.f;
#pragma unroll
            for (int bj = 0; bj < 2; ++bj) {
                const int col = col0 + bj * HALF;
                float o[8];
                if (IN_BF16) { const u32x4 w = xw[g][bj]; o[0] = bf_lo(w.x); o[1] = bf_hi(w.x); o[2] = bf_lo(w.y); o[3] = bf_hi(w.y); o[4] = bf_lo(w.z); o[5] = bf_hi(w.z); o[6] = bf_lo(w.w); o[7] = bf_hi(w.w); }
                else { const f32x4 a0 = xi[g][2 * bj], a1 = xi[g][2 * bj + 1]; o[0] = a0[0]; o[1] = a0[1]; o[2] = a0[2]; o[3] = a0[3]; o[4] = a1[0]; o[5] = a1[1]; o[6] = a1[2]; o[7] = a1[3]; }
#pragma unroll
                for (int e = 0; e < 8; ++e) o[e] += acc[ai][bj][m][e >> 2][e & 3] * scale;
                if (OUT_BF16) *(u32x4*)(xb + (size_t)row * DM + col) = pack8(o);
                else { float* xout = xo + (size_t)row * DM + col; *(f32x4*)xout = (f32x4){o[0], o[1], o[2], o[3]}; *(f32x4*)(xout + 4) = (f32x4){o[4], o[5], o[6], o[7]}; }
#pragma unroll
                for (int e = 0; e < 8; ++e) sq += o[e] * o[e];
            }
            sq += __shfl_xor(sq, 16); sq += __shfl_xor(sq, 32);
            if (fq == 0) atomicAdd(ss + row, sq);
            if (g == 0) RES_LOAD(2); if (g == 1) RES_LOAD(3); if (g == 2) RES_LOAD(4); if (g == 3) RES_LOAD(5); if (g == 4) RES_LOAD(6); if (g == 5) RES_LOAD(7);
        }
#undef RES_LOAD
    }
};
struct EpiWin {
    static constexpr bool PERM = true, AFTER_DRAIN = false;
    const float* ss; bf16_t* QB; bf16_t* KB; bf16_t* VB; float* dout; bf16_t* U; bf16_t* GA; bf16_t* GB;
    __device__ __forceinline__ void operator()(const f32x4 (&acc)[2][2][4][2], const Unit& u, int wr, int wc, int fr, int fq) const {
        const int pn = u.pn, row0 = u.pm * BM + wr * 64 + fr, cl = wc * 32 + 8 * fq;
        float rsv[8];
#pragma unroll
        for (int g = 0; g < 8; ++g) rsv[g] = ss[row0 + (g >> 2) * HALF + (g & 3) * 16];
        asm volatile("" : "+v"(rsv[0]), "+v"(rsv[1]), "+v"(rsv[2]), "+v"(rsv[3]), "+v"(rsv[4]), "+v"(rsv[5]), "+v"(rsv[6]), "+v"(rsv[7]));
#pragma unroll
        for (int ai = 0; ai < 2; ++ai)
#pragma unroll
            for (int m = 0; m < 4; ++m) {
                const int row = row0 + ai * HALF + m * 16;
                const float rs = rsqrtf(rsv[ai * 4 + m] * (1.0f / 2048.0f) + 1e-6f);
#pragma unroll
                for (int bj = 0; bj < 2; ++bj) {
                    const int c = cl + bj * HALF;
                    float o[8];
#pragma unroll
                    for (int n = 0; n < 2; ++n)
#pragma unroll
                        for (int e = 0; e < 4; ++e) o[4 * n + e] = acc[ai][bj][m][n][e] * rs;
                    if (pn < 4) {
#pragma unroll
                        for (int e = 0; e < 8; ++e) o[e] *= QSCALE;
                        *(u32x4*)(QB + (size_t)row * 1024 + pn * 256 + c) = pack8(o);
                    } else if (pn < 12) {
                        const bool isk = pn < 8; const int col = (isk ? pn - 4 : pn - 8) * 256 + c;
                        float* fo = (row < MP) ? dout + (isk ? OFF_KP : OFF_VP) + (size_t)row * 1024 + col : dout + (isk ? OFF_KS : OFF_VS) + (size_t)(row - MP) * 1024 + col;
                        *(f32x4*)fo = (f32x4){o[0], o[1], o[2], o[3]}; *(f32x4*)(fo + 4) = (f32x4){o[4], o[5], o[6], o[7]};
                        if (row < MP) *(u32x4*)((isk ? KB : VB) + (size_t)row * 1024 + col) = pack8(o);
                    } else if (pn < 26) {
                        const int col = (pn - 12) * 256 + c;
                        *(u32x4*)(U + (size_t)row * 3584 + col) = pack8(o);
                        if (col < 3520) {
                            float* so = nullptr;
                            if (row < MP) { if ((row & 8191) == 8191) so = dout + OFF_SHP + (size_t)(row >> 13) * 3520 + col; }
                            else { if (((row - MP) & 63) == 63) so = dout + OFF_SHS + (size_t)((row - MP) >> 6) * 3520 + col; }
                            if (so) { *(f32x4*)so = (f32x4){o[0], o[1], o[2], o[3]}; *(f32x4*)(so + 4) = (f32x4){o[4], o[5], o[6], o[7]}; }
                        }
                    } else {
                        const bool isa = pn < 34; const int col = (isa ? pn - 26 : pn - 34) * 256 + c;
#pragma unroll
                        for (int e = 0; e < 8; ++e) o[e] = sigm(o[e]);
                        *(u32x4*)((isa ? GA : GB) + (size_t)row * DM + col) = pack8(o);
                    }
                }
            }
    }
};
struct EpiLora {
    static constexpr bool PERM = true, AFTER_DRAIN = false;
    const float* w0; const float* a0; bf16_t* LW; bf16_t* AS; bf16_t* GG;
    __device__ __forceinline__ void operator()(const f32x4 (&acc)[2][2][4][2], const Unit& u, int wr, int wc, int fr, int fq) const {
        const int pn = u.pn, row0 = u.pm * BM + wr * 64 + fr, cl = wc * 32 + 8 * fq;
        f32x4 bias[2][2];
#pragma unroll
        for (int bj = 0; bj < 2; ++bj) { const int col = (pn & 3) * 256 + cl + bj * HALF; const float* bp = (pn < 4) ? w0 + col : a0 + col;
            if (pn < 8) { bias[bj][0] = *(const f32x4*)bp; bias[bj][1] = *(const f32x4*)(bp + 4); } else { bias[bj][0] = (f32x4){0.f, 0.f, 0.f, 0.f}; bias[bj][1] = bias[bj][0]; } }
#pragma unroll
        for (int ai = 0; ai < 2; ++ai)
#pragma unroll
            for (int m = 0; m < 4; ++m) {
                const int row = row0 + ai * HALF + m * 16;
#pragma unroll
                for (int bj = 0; bj < 2; ++bj) {
                    const int col = (pn & 3) * 256 + cl + bj * HALF;
                    float o[8];
#pragma unroll
                    for (int n = 0; n < 2; ++n)
#pragma unroll
                        for (int e = 0; e < 4; ++e) o[4 * n + e] = acc[ai][bj][m][n][e] + bias[bj][n][e];
                    if (pn < 4) {
#pragma unroll
                        for (int e = 0; e < 8; ++e) { const float wv = -__logf(1.0f + __expf(-o[e])) - 0.5f; o[e] = -__expf(wv); }
                        *(u32x4*)(LW + (size_t)row * 1024 + col) = pack8(o);
                    } else if (pn < 8) {
#pragma unroll
                        for (int e = 0; e < 8; ++e) o[e] = sigm(o[e]);
                        *(u32x4*)(AS + (size_t)row * 1024 + col) = pack8(o);
                    } else {
                        *(u32x4*)(GG + (size_t)row * 1024 + col) = pack8(o);
                    }
                }
            }
    }
};
template <bool ADD> struct EpiProj {
    static constexpr bool PERM = true, AFTER_DRAIN = false;
    const bf16_t* GT; bf16_t* MG;
    __device__ __forceinline__ void operator()(const f32x4 (&acc)[2][2][4][2], const Unit& u, int wr, int wc, int fr, int fq) const {
        const int row0 = u.pm * BM + wr * 64 + fr, col0 = u.pn * BM + wc * 32 + 8 * fq;
        u32x4 gi[8][2], pi[8][2];
#define PRJ_LOAD(g) do { const size_t off_ = (size_t)(row0 + ((g) >> 2) * HALF + ((g) & 3) * 16) * DM + col0; gi[g][0] = *(const u32x4*)(GT + off_); gi[g][1] = *(const u32x4*)(GT + off_ + HALF); \
        if (ADD) { pi[g][0] = *(const u32x4*)(MG + off_); pi[g][1] = *(const u32x4*)(MG + off_ + HALF); } } while (0)
        PRJ_LOAD(0); PRJ_LOAD(1);
#pragma unroll
        for (int g = 0; g < 8; ++g) {
            const int ai = g >> 2, m = g & 3, row = row0 + ai * HALF + m * 16;
#pragma unroll
            for (int bj = 0; bj < 2; ++bj) {
                const size_t off = (size_t)row * DM + col0 + bj * HALF;
                const u32x4 gt = gi[g][bj];
                float o[8];
#pragma unroll
                for (int n = 0; n < 2; ++n)
#pragma unroll
                    for (int e = 0; e < 4; ++e) o[4 * n + e] = acc[ai][bj][m][n][e];
                o[0] *= bf_lo(gt.x); o[1] *= bf_hi(gt.x); o[2] *= bf_lo(gt.y); o[3] *= bf_hi(gt.y); o[4] *= bf_lo(gt.z); o[5] *= bf_hi(gt.z); o[6] *= bf_lo(gt.w); o[7] *= bf_hi(gt.w);
                if (ADD) { const u32x4 p = pi[g][bj];
                    o[0] += bf_lo(p.x); o[1] += bf_hi(p.x); o[2] += bf_lo(p.y); o[3] += bf_hi(p.y); o[4] += bf_lo(p.z); o[5] += bf_hi(p.z); o[6] += bf_lo(p.w); o[7] += bf_hi(p.w); }
                *(u32x4*)(MG + off) = pack8(o);
            }
            if (g == 0) PRJ_LOAD(2); if (g == 1) PRJ_LOAD(3); if (g == 2) PRJ_LOAD(4); if (g == 3) PRJ_LOAD(5); if (g == 4) PRJ_LOAD(6); if (g == 5) PRJ_LOAD(7);
        }
#undef PRJ_LOAD
    }
};

struct PanelOrder {
    int c, mode;
    __device__ __forceinline__ bool next(int i, Unit& u) const {
        if (mode == 0) { if (i >= 4) return false; const int x = c & 7, s = c >> 3; u.pm = i * 32 + x * 4 + (s >> 3); u.pn = s & 7; u.oa = 0; return true; }
        if (i >= 1 || c >= 64) return false; u.pm = 128 + (c & 7); u.pn = c >> 3; u.oa = 0; return true;
    }
    __device__ __forceinline__ void a_ready(const Unit&) const {}
    __device__ __forceinline__ void done(const Unit&) const {}
};
struct RangeOrder {
    int nM, nN, q, x, s, ns, base, cnt;
    __device__ __forceinline__ bool next(int i, Unit& u) const {
        const int j = s + ns * i; if (s < 0 || j >= cnt) return false;
        const int wgid = x * q + base + j, nig = WGM * nN, gid = wgid / nig, fm = gid * WGM, gsz = (nM - fm) < WGM ? (nM - fm) : WGM;
        u.pm = fm + ((wgid % nig) % gsz); u.pn = (wgid % nig) / gsz; u.oa = 0; return true;
    }
    __device__ __forceinline__ void a_ready(const Unit&) const {}
    __device__ __forceinline__ void done(const Unit&) const {}
};
struct LoraOrder {
    StaticOrder so;
    __device__ __forceinline__ bool next(int i, Unit& u) const { if (!so.next(i, u)) return false; u.oa = (u.pn >> 2) * (MROWS * 256 * 2); return true; }
    __device__ __forceinline__ void a_ready(const Unit&) const {}
    __device__ __forceinline__ void done(const Unit&) const {}
};
template <class Epi, class Sched, bool ALIGN_EPI = false, bool SP2 = false>
__device__ __forceinline__ void gemm_phase(PG8_LAS unsigned char* lds, const Gemm g, const Sched& S, const Epi& E) {
    const int tid = threadIdx.x, wid = __builtin_amdgcn_readfirstlane(tid >> 6), lane = tid & 63, wr = wid >> 2, wc = wid & 3, fr = lane & 15, fq = lane >> 4;
    const int K = g.K, nt = K / BK, lda = K;
    unsigned voffA[2], voffB[2];
#pragma unroll
    for (int i = 0; i < 2; ++i) { int R, C; stage_rc(tid * 16 + i * 8192, R, C); const int Rb = Epi::PERM ? ((R & ~31) + perm32(R & 31)) : R;
        voffA[i] = (unsigned)(R * lda + C) * 2u; voffB[i] = (unsigned)(Rb * K + C) * 2u; }
    const size_t kstep = (size_t)(BK * 2);
    const size_t hstep = (size_t)HALF * K * 2;
    const size_t tstep = 2 * hstep;
    const size_t hstepA = (size_t)HALF * lda * 2, tstepA = 2 * hstepA;
    const unsigned ldsw = (unsigned)wid * 1024u;
    const int aoff = lds_byte(wr * 64 + fr, fq * 8), boff = lds_byte(wc * 32 + fr, fq * 8);
#define PG8_SA(b, h) (((b) * 2 + (h)) * HTB)
#define PG8_SB(b, h) ((4 + (b) * 2 + (h)) * HTB)
#define PG8_STAGE(bufoff, gbase, voff) do { _Pragma("unroll") for (int _i = 0; _i < 2; ++_i) \
        __builtin_amdgcn_global_load_lds((const unsigned*)((const char*)(gbase) + (voff)[_i]), (PG8_LAS unsigned*)(lds + (bufoff) + ldsw + _i * 8192), 16, 0, 0); } while (0)
#define PG8_LDA(dst, b, h) do { _Pragma("unroll") for (int m = 0; m < 4; ++m) _Pragma("unroll") for (int k = 0; k < 2; ++k) dst[m][k] = *(const PG8_LAS bf16x8*)(lds + PG8_SA(b, h) + aoff + m * 2048 + k * 1024); } while (0)
#define PG8_LDB(dst, b, h) do { _Pragma("unroll") for (int n = 0; n < 2; ++n) _Pragma("unroll") for (int k = 0; k < 2; ++k) dst[n][k] = *(const PG8_LAS bf16x8*)(lds + PG8_SB(b, h) + boff + n * 2048 + k * 1024); } while (0)
#define PG8_MMA(ai, bj, At, Bt) do { __builtin_amdgcn_s_setprio(1); _Pragma("unroll") for (int m = 0; m < 4; ++m) _Pragma("unroll") for (int n = 0; n < 2; ++n) _Pragma("unroll") for (int k = 0; k < 2; ++k) \
        acc[ai][bj][m][n] = __builtin_amdgcn_mfma_f32_16x16x32_bf16(Bt[n][k], At[m][k], acc[ai][bj][m][n], 0, 0, 0); __builtin_amdgcn_s_setprio(0); } while (0)
#define PG8_WAIT_V(n) asm volatile("s_waitcnt vmcnt(" #n ")" ::: "memory")
#define PG8_WAIT_L(n) asm volatile("s_waitcnt lgkmcnt(" #n ")" ::: "memory")
#define PG8_BAR __builtin_amdgcn_s_barrier()
#define PG8_SCHED __builtin_amdgcn_sched_barrier(0)
    Unit cur, nxt; int ui = 0;
    if (!S.next(0, cur)) return;
    f32x4 acc[2][2][4][2];
#pragma unroll
    for (int a = 0; a < 2; ++a)
#pragma unroll
        for (int b = 0; b < 2; ++b)
#pragma unroll
            for (int m = 0; m < 4; ++m)
#pragma unroll
                for (int n = 0; n < 2; ++n) acc[a][b][m][n] = (f32x4){0.f, 0.f, 0.f, 0.f};
    bf16x8 At[4][2], B0[2][2], B1[2][2];
    const char* cA = (const char*)g.A + (size_t)cur.pm * tstepA + cur.oa; const char* cB = (const char*)g.Bt + (size_t)cur.pn * tstep;
    S.a_ready(cur);
    if constexpr (SP2) {
        PG8_STAGE(PG8_SB(0, 0), cB, voffB); PG8_STAGE(PG8_SB(0, 1), cB + hstep, voffB); PG8_STAGE(PG8_SA(0, 0), cA, voffA); PG8_STAGE(PG8_SA(0, 1), cA + hstepA, voffA);
        if (wr == 1) PG8_BAR;
        PG8_WAIT_V(2); PG8_BAR;
        PG8_STAGE(PG8_SB(1, 0), cB + kstep, voffB); PG8_STAGE(PG8_SA(1, 0), cA + kstep, voffA); PG8_STAGE(PG8_SB(1, 1), cB + hstep + kstep, voffB);
        PG8_WAIT_V(6); PG8_BAR;
    } else {
        PG8_STAGE(PG8_SB(0, 0), cB, voffB); PG8_STAGE(PG8_SA(0, 0), cA, voffA); PG8_STAGE(PG8_SB(0, 1), cB + hstep, voffB); PG8_STAGE(PG8_SA(0, 1), cA + hstepA, voffA);
        if (wr == 1) PG8_BAR;
        PG8_WAIT_V(4); PG8_BAR;
        PG8_STAGE(PG8_SB(1, 0), cB + kstep, voffB); PG8_STAGE(PG8_SA(1, 0), cA + kstep, voffA); PG8_STAGE(PG8_SB(1, 1), cB + hstep + kstep, voffB);
        PG8_WAIT_V(6); PG8_BAR;
    }
    for (;;) {
        const bool has_next = S.next(ui + 1, nxt);
        const char* nA = has_next ? (const char*)g.A + (size_t)nxt.pm * tstepA + nxt.oa : cA; const char* nB = has_next ? (const char*)g.Bt + (size_t)nxt.pn * tstep : cB;
#pragma unroll 1
        for (int t = 0; t < nt; t += 2) {
            const bool last = (t == nt - 2);
            const char* a1 = cA + (size_t)(t + 1) * kstep;
            const char* a2 = last ? nA : cA + (size_t)(t + 2) * kstep; const char* b2 = last ? nB : cB + (size_t)(t + 2) * kstep;
            const char* a3 = a2 + kstep; const char* b3 = b2 + kstep;
            if (last && has_next) S.a_ready(nxt);
            if constexpr (SP2) {
            PG8_LDB(B0, 0, 0); PG8_LDB(B1, 0, 1); PG8_SCHED; PG8_LDA(At, 0, 0); PG8_STAGE(PG8_SA(1, 1), a1 + hstepA, voffA);
            PG8_WAIT_V(8); PG8_WAIT_L(0); PG8_BAR; PG8_MMA(0, 0, At, B0); PG8_MMA(0, 1, At, B1); PG8_BAR; PG8_SCHED;
            PG8_LDA(At, 0, 1); PG8_STAGE(PG8_SB(0, 0), b2, voffB); PG8_STAGE(PG8_SB(0, 1), b2 + hstep, voffB); PG8_STAGE(PG8_SA(0, 0), a2, voffA);
            PG8_WAIT_V(8); PG8_WAIT_L(0); PG8_BAR; PG8_MMA(1, 0, At, B0); PG8_MMA(1, 1, At, B1); PG8_BAR; PG8_SCHED;
            PG8_LDB(B0, 1, 0); PG8_LDB(B1, 1, 1); PG8_SCHED; PG8_LDA(At, 1, 0); PG8_STAGE(PG8_SA(0, 1), a2 + hstepA, voffA);
            PG8_WAIT_V(8); PG8_WAIT_L(0); PG8_BAR; PG8_MMA(0, 0, At, B0); PG8_MMA(0, 1, At, B1); PG8_BAR; PG8_SCHED;
            PG8_LDA(At, 1, 1); PG8_STAGE(PG8_SB(1, 0), b3, voffB); PG8_STAGE(PG8_SB(1, 1), b3 + hstep, voffB); PG8_STAGE(PG8_SA(1, 0), a3, voffA);
            PG8_WAIT_V(8); PG8_WAIT_L(0); PG8_BAR; PG8_MMA(1, 0, At, B0); PG8_MMA(1, 1, At, B1); PG8_BAR; PG8_SCHED;
            } else {
            PG8_LDB(B0, 0, 0); PG8_SCHED; PG8_LDA(At, 0, 0); PG8_STAGE(PG8_SA(1, 1), a1 + hstepA, voffA);
            PG8_WAIT_L(8); PG8_BAR; PG8_WAIT_L(0); PG8_MMA(0, 0, At, B0); PG8_BAR; PG8_SCHED;
            PG8_LDB(B1, 0, 1); PG8_STAGE(PG8_SB(0, 0), b2, voffB);
            PG8_BAR; PG8_WAIT_L(0); PG8_MMA(0, 1, At, B1); PG8_BAR;
            PG8_LDA(At, 0, 1); PG8_STAGE(PG8_SA(0, 0), a2, voffA);
            PG8_BAR; PG8_WAIT_L(0); PG8_MMA(1, 0, At, B0); PG8_BAR; PG8_SCHED;
            PG8_STAGE(PG8_SB(0, 1), b2 + hstep, voffB);
            PG8_WAIT_V(6); PG8_BAR; PG8_MMA(1, 1, At, B1); PG8_BAR;
            PG8_LDB(B0, 1, 0); PG8_SCHED; PG8_LDA(At, 1, 0); PG8_STAGE(PG8_SA(0, 1), a2 + hstepA, voffA);
            PG8_WAIT_L(8); PG8_BAR; PG8_WAIT_L(0); PG8_MMA(0, 0, At, B0); PG8_BAR; PG8_SCHED;
            PG8_LDB(B1, 1, 1); PG8_STAGE(PG8_SB(1, 0), b3, voffB);
            PG8_BAR; PG8_WAIT_L(0); PG8_MMA(0, 1, At, B1); PG8_BAR;
            PG8_LDA(At, 1, 1); PG8_STAGE(PG8_SA(1, 0), a3, voffA);
            PG8_BAR; PG8_WAIT_L(0); PG8_MMA(1, 0, At, B0); PG8_BAR; PG8_SCHED;
            PG8_STAGE(PG8_SB(1, 1), b3 + hstep, voffB);
            PG8_WAIT_V(6); PG8_BAR; PG8_MMA(1, 1, At, B1); PG8_BAR;
            }
        }
        if constexpr (ALIGN_EPI) { if (wr == 0) PG8_BAR; }
        if constexpr (!Epi::AFTER_DRAIN) { E(acc, cur, wr, wc, fr, fq); S.done(cur); }
        if (!has_next) break;
#pragma unroll
        for (int a = 0; a < 2; ++a)
#pragma unroll
            for (int b = 0; b < 2; ++b)
#pragma unroll
                for (int m = 0; m < 4; ++m)
#pragma unroll
                    for (int n = 0; n < 2; ++n) acc[a][b][m][n] = (f32x4){0.f, 0.f, 0.f, 0.f};
        cur = nxt; cA = nA; cB = nB; ++ui;
        if constexpr (ALIGN_EPI) { if (wr == 1) PG8_BAR; }
    }
    PG8_WAIT_V(0);
    if constexpr (!ALIGN_EPI) { if (wr == 0) PG8_BAR; }
    PG8_BAR;
    if constexpr (Epi::AFTER_DRAIN) { E.fused(acc, cur, wr, wc, fr, fq, lds, wid, lane); S.done(cur); }
#undef PG8_SA
#undef PG8_SB
#undef PG8_STAGE
#undef PG8_LDA
#undef PG8_LDB
#undef PG8_MMA
#undef PG8_WAIT_V
#undef PG8_WAIT_L
#undef PG8_BAR
#undef PG8_SCHED
}
}
#define LAS __attribute__((address_space(3)))
#define GAS __attribute__((address_space(1)))
typedef unsigned short bf16_t;
typedef short bf16x8 __attribute__((ext_vector_type(8)));
typedef short s16x4 __attribute__((ext_vector_type(4)));
typedef float f32x4 __attribute__((ext_vector_type(4)));
typedef float f32x16 __attribute__((ext_vector_type(16)));
typedef unsigned u32x4 __attribute__((ext_vector_type(4)));
typedef unsigned u32x2 __attribute__((ext_vector_type(2)));
typedef float f32x2_t __attribute__((ext_vector_type(2)));
typedef __bf16 bf16x2_t __attribute__((ext_vector_type(2)));
__device__ __forceinline__ unsigned cvtpk(float lo, float hi) { f32x2_t v = {lo, hi}; bf16x2_t b = __builtin_convertvector(v, bf16x2_t); return __builtin_bit_cast(unsigned, b); }
__device__ __forceinline__ u32x4 pk8(const float* o) { u32x4 w; w.x = cvtpk(o[0], o[1]); w.y = cvtpk(o[2], o[3]); w.z = cvtpk(o[4], o[5]); w.w = cvtpk(o[6], o[7]); return w; }
__device__ __forceinline__ float bflo(unsigned w) { return __uint_as_float(w << 16); }
__device__ __forceinline__ float bfhi(unsigned w) { return __uint_as_float(w & 0xffff0000u); }
__device__ __forceinline__ void unpk8(const u32x4 w, float* o) { o[0] = bflo(w.x); o[1] = bfhi(w.x); o[2] = bflo(w.y); o[3] = bfhi(w.y); o[4] = bflo(w.z); o[5] = bfhi(w.z); o[6] = bflo(w.w); o[7] = bfhi(w.w); }
__device__ __forceinline__ int crow(int r, int hi) { return (r & 3) + 8 * (r >> 2) + 4 * hi; }
__device__ __forceinline__ float swap_add(float v) { auto rr = __builtin_amdgcn_permlane32_swap(__float_as_uint(v), __float_as_uint(v), false, false); return __uint_as_float(rr[0]) + __uint_as_float(rr[1]); }
__device__ __forceinline__ float swap_max(float v) { auto rr = __builtin_amdgcn_permlane32_swap(__float_as_uint(v), __float_as_uint(v), false, false); return fmaxf(__uint_as_float(rr[0]), __uint_as_float(rr[1])); }
#define WG_BAR() do { asm volatile("s_waitcnt lgkmcnt(0)" ::: "memory"); __builtin_amdgcn_s_barrier(); asm volatile("" ::: "memory"); } while (0)
typedef short v4i16_t __attribute__((ext_vector_type(4)));
typedef unsigned long long u64x2 __attribute__((ext_vector_type(2)));
__device__ __forceinline__ unsigned long long vtr64(const LAS unsigned char* p) { return __builtin_bit_cast(unsigned long long, __builtin_amdgcn_ds_read_tr16_b64_v4i16((LAS v4i16_t*)p)); }
__device__ __forceinline__ s16x4 vtr(const LAS unsigned char* p) { return __builtin_bit_cast(s16x4, __builtin_amdgcn_ds_read_tr16_b64_v4i16((LAS v4i16_t*)p)); }

namespace att {
constexpr int KT = 16384, BUF = 32768, CBS = 132, WSF_OFF = 3 * BUF, LDS_NEED = WSF_OFF + 8 * 256;
struct Src { const void* k; const void* v; const float* kn; const float* vn; };
template <bool F32> struct Stage;
template <> struct Stage<false> { u32x4 k[2], v[2]; };
template <> struct Stage<true> { f32x4 k[2][2], v[2][2]; };

template <bool F32> __device__ __forceinline__ void tile_load(Stage<F32>& s, const Src& S, int t, int wid, int lane) {
    if constexpr (F32) {
        const float* kb = (t < 64) ? (const float*)S.k + (size_t)t * 65536 : S.kn;
        const float* vb = (t < 64) ? (const float*)S.v + (size_t)t * 65536 : S.vn;
#pragma unroll
        for (int i = 0; i < 2; ++i) { const float* p = kb + (size_t)lane * 1024 + (wid + 8 * i) * 8; s.k[i][0] = *(const f32x4*)p; s.k[i][1] = *(const f32x4*)(p + 4); }
#pragma unroll
        for (int i = 0; i < 2; ++i) { const int pp = wid + 8 * i, db = pp >> 2, kg = pp & 3; const float* p = vb + (size_t)(16 * kg + (lane >> 2)) * 1024 + db * 32 + (lane & 3) * 8; s.v[i][0] = *(const f32x4*)p; s.v[i][1] = *(const f32x4*)(p + 4); }
    } else {
        const bf16_t* kb = (const bf16_t*)S.k + (size_t)t * 65536;
        const bf16_t* vb = (const bf16_t*)S.v + (size_t)t * 65536;
#pragma unroll
        for (int i = 0; i < 2; ++i) s.k[i] = *(const u32x4*)(kb + (size_t)lane * 1024 + (wid + 8 * i) * 8);
#pragma unroll
        for (int i = 0; i < 2; ++i) { const int pp = wid + 8 * i, db = pp >> 2, kg = pp & 3; s.v[i] = *(const u32x4*)(vb + (size_t)(16 * kg + (lane >> 2)) * 1024 + db * 32 + (lane & 3) * 8); }
    }
}
template <bool F32> __device__ __forceinline__ void tile_store(const Stage<F32>& s, LAS unsigned char* buf, int wid, int lane) {
#pragma unroll
    for (int i = 0; i < 2; ++i) {
        u32x4 kv, vv;
        if constexpr (F32) { float a[8] = {s.k[i][0][0], s.k[i][0][1], s.k[i][0][2], s.k[i][0][3], s.k[i][1][0], s.k[i][1][1], s.k[i][1][2], s.k[i][1][3]}; kv = pk8(a);
                             float b[8] = {s.v[i][0][0], s.v[i][0][1], s.v[i][0][2], s.v[i][0][3], s.v[i][1][0], s.v[i][1][1], s.v[i][1][2], s.v[i][1][3]}; vv = pk8(b); }
        else { kv = s.k[i]; vv = s.v[i]; }
        *(LAS u32x4*)(buf + (wid + 8 * i) * 1024 + lane * 16) = kv;
        *(LAS u32x4*)(buf + KT + (wid + 8 * i) * 1024 + lane * 16) = vv;
    }
}

template <bool F32>
__device__ __forceinline__ void unit(LAS unsigned char* lds, const bf16_t* Qu, const Src& S, int nt_lo, int nt_hi, bf16_t* Ou, float lam, const float* subg) {
    const int tid = threadIdx.x, lane = tid & 63, wid = __builtin_amdgcn_readfirstlane(tid >> 6), r32 = lane & 31, hi = lane >> 5;
    const int c = F32 ? ((wid >> 1) & 1) : (wid >> 2), rb = F32 ? ((wid < 4) ? (wid & 1) : 2 + (wid & 1)) : (wid & 3);
    const int ntw = (rb < 2) ? nt_lo : nt_hi, NT = nt_lo > nt_hi ? nt_lo : nt_hi;
    const bool active = ntw > 0, late = c == 1;
    bf16x8 qr[4];
#pragma unroll
    for (int d0 = 0; d0 < 4; ++d0) { if (active) qr[d0] = *(const bf16x8*)(Qu + (size_t)(32 * rb + r32) * 1024 + c * 64 + d0 * 16 + hi * 8); else qr[d0] = (bf16x8){0, 0, 0, 0, 0, 0, 0, 0}; }
    float mrun = 0.f, l = 0.f;
    f32x16 o[4];
#pragma unroll
    for (int d0 = 0; d0 < 4; ++d0)
#pragma unroll
        for (int r = 0; r < 16; ++r) o[d0][r] = 0.f;
    bf16x8 pa[4];
#pragma unroll
    for (int ks = 0; ks < 4; ++ks) pa[ks] = (bf16x8){0, 0, 0, 0, 0, 0, 0, 0};
    f32x16 negm;
#pragma unroll
    for (int r = 0; r < 16; ++r) negm[r] = 0.f;
    asm volatile("" : "+v"(negm));
    LAS float* wsf = (LAS float*)(lds + WSF_OFF + wid * 256);
    Stage<F32> st;
    tile_load<F32>(st, S, 0, wid, lane);
    tile_store<F32>(st, lds, wid, lane);
    if (NT > 1) tile_load<F32>(st, S, 1, wid, lane);
    WG_BAR();
    const int vlane = ((lane >> 4) & 1) * 32 + (lane & 3) * 8 + (4 * hi + ((lane & 15) >> 2)) * 64;
#define ATT_PV(bufp) do { const LAS unsigned char* vp_ = (bufp) + KT + vlane; \
        _Pragma("unroll") for (int d0 = 0; d0 < 4; ++d0) \
            _Pragma("unroll") for (int ks = 0; ks < 4; ++ks) { \
                u64x2 vq_; vq_.x = vtr64(vp_ + d0 * 4096 + ks * 1024); vq_.y = vtr64(vp_ + d0 * 4096 + ks * 1024 + 512);     \
                o[d0] = __builtin_amdgcn_mfma_f32_32x32x16_bf16(pa[ks], __builtin_bit_cast(bf16x8, vq_), o[d0], 0, 0, 0); } } while (0)
    int b_cur = 0, b_prev = 2 * BUF, b_next = BUF;
    for (int t = 0; t <= NT; ++t) {
        if (t + 1 < NT) tile_store<F32>(st, lds + b_next, wid, lane);
        if (t + 2 < NT) tile_load<F32>(st, S, t + 2, wid, lane);
        if (late && t >= 1 && t - 1 < ntw) ATT_PV(lds + b_prev);
        if (t < ntw) {
            LAS unsigned char* buf = lds + b_cur;
            f32x16 p0, p1;
            const LAS unsigned char* kb = buf + (8 * c + hi) * 1024 + r32 * 16;
#pragma unroll
            for (int d0 = 0; d0 < 4; ++d0) {
                const bf16x8 b0 = *(const LAS bf16x8*)(kb + d0 * 2048), b1 = *(const LAS bf16x8*)(kb + d0 * 2048 + 512);
                if (d0 == 0) { p0 = __builtin_amdgcn_mfma_f32_32x32x16_bf16(b0, qr[0], negm, 0, 0, 0); p1 = __builtin_amdgcn_mfma_f32_32x32x16_bf16(b1, qr[0], negm, 0, 0, 0); }
                else { p0 = __builtin_amdgcn_mfma_f32_32x32x16_bf16(b0, qr[d0], p0, 0, 0, 0); p1 = __builtin_amdgcn_mfma_f32_32x32x16_bf16(b1, qr[d0], p1, 0, 0, 0); }
            }
            float rm = fmaxf(fmaxf(p0[0], p0[1]), p1[0]);
#pragma unroll
            for (int r = 2; r < 16; r += 2) rm = fmaxf(fmaxf(rm, p0[r]), p0[r + 1]);
            rm = fmaxf(rm, p1[1]);
#pragma unroll
            for (int r = 2; r < 16; r += 2) rm = fmaxf(fmaxf(rm, p1[r]), p1[r + 1]);
            rm = swap_max(rm);
            if (t == 0 || __any(rm > 8.0f)) {
                const float dl = (t == 0) ? rm : fmaxf(rm, 0.f), alpha = (t == 0) ? 1.0f : __builtin_amdgcn_exp2f(-dl);
                mrun += dl; l *= alpha;
#pragma unroll
                for (int r = 0; r < 16; ++r) negm[r] = -mrun;
                asm volatile("" : "+v"(negm));
                if (hi == 0) wsf[r32] = alpha;
#pragma unroll
                for (int r = 0; r < 16; ++r) { p0[r] -= dl; p1[r] -= dl; const float f = wsf[crow(r, hi)];
#pragma unroll
                    for (int d0 = 0; d0 < 4; ++d0) o[d0][r] *= f; }
            }
            float sacc = 0.f;
#pragma unroll
            for (int r = 0; r < 16; ++r) { p0[r] = __builtin_amdgcn_exp2f(p0[r]); p1[r] = __builtin_amdgcn_exp2f(p1[r]); sacc += p0[r]; asm volatile("" : "+v"(sacc)); sacc += p1[r]; asm volatile("" : "+v"(sacc)); }
            l += sacc;
            { u32x4 w;
              w.x = cvtpk(p0[0], p0[1]); w.y = cvtpk(p0[2], p0[3]); w.z = cvtpk(p0[4], p0[5]); w.w = cvtpk(p0[6], p0[7]); pa[0] = __builtin_bit_cast(bf16x8, w);
              w.x = cvtpk(p0[8], p0[9]); w.y = cvtpk(p0[10], p0[11]); w.z = cvtpk(p0[12], p0[13]); w.w = cvtpk(p0[14], p0[15]); pa[1] = __builtin_bit_cast(bf16x8, w);
              w.x = cvtpk(p1[0], p1[1]); w.y = cvtpk(p1[2], p1[3]); w.z = cvtpk(p1[4], p1[5]); w.w = cvtpk(p1[6], p1[7]); pa[2] = __builtin_bit_cast(bf16x8, w);
              w.x = cvtpk(p1[8], p1[9]); w.y = cvtpk(p1[10], p1[11]); w.z = cvtpk(p1[12], p1[13]); w.w = cvtpk(p1[14], p1[15]); pa[3] = __builtin_bit_cast(bf16x8, w); }
            if (!late) ATT_PV(buf);
        }
        WG_BAR();
        { const int tmp = b_prev; b_prev = b_cur; b_cur = b_next; b_next = tmp; }
    }
#undef ATT_PV
    if (active) {
        const float lt = swap_add(l), inv = 1.0f / lt;
        if (hi == 0) wsf[r32] = inv;
#pragma unroll
        for (int r = 0; r < 16; ++r) { const float f = wsf[crow(r, hi)];
#pragma unroll
            for (int d0 = 0; d0 < 4; ++d0) o[d0][r] *= f; }
    }
    LAS float* cb = (LAS float*)lds;
    if (active && c == 1) {
#pragma unroll
        for (int d0 = 0; d0 < 4; ++d0)
#pragma unroll
            for (int r = 0; r < 16; ++r) cb[(32 * rb + crow(r, hi)) * CBS + 32 * d0 + r32] = o[d0][r];
    }
    WG_BAR();
    if (active && c == 0) {
#pragma unroll
        for (int d0 = 0; d0 < 4; ++d0)
#pragma unroll
            for (int r = 0; r < 16; ++r) { const int idx = (32 * rb + crow(r, hi)) * CBS + 32 * d0 + r32; cb[idx] = o[d0][r] - lam * cb[idx]; }
        asm volatile("s_waitcnt lgkmcnt(0)" ::: "memory");
        const int q = 32 * rb + r32;
        f32x4 vals[16]; float ssq = 0.f;
#pragma unroll
        for (int j = 0; j < 16; ++j) { vals[j] = *(const LAS f32x4*)(cb + q * CBS + 64 * hi + 4 * j); ssq += vals[j][0] * vals[j][0] + vals[j][1] * vals[j][1] + vals[j][2] * vals[j][2] + vals[j][3] * vals[j][3]; }
        ssq = swap_add(ssq);
        const float rs = rsqrtf(ssq * (1.0f / 128.0f) + 1e-5f) * 0.8f;
#pragma unroll
        for (int j = 0; j < 16; j += 2) {
            const f32x4 g0 = *(const f32x4*)(subg + 64 * hi + 4 * j), g1 = *(const f32x4*)(subg + 64 * hi + 4 * j + 4);
            float ov[8] = {vals[j][0] * rs * g0[0], vals[j][1] * rs * g0[1], vals[j][2] * rs * g0[2], vals[j][3] * rs * g0[3],
                           vals[j + 1][0] * rs * g1[0], vals[j + 1][1] * rs * g1[1], vals[j + 1][2] * rs * g1[2], vals[j + 1][3] * rs * g1[3]};
            *(u32x4*)(Ou + (size_t)q * 1024 + 64 * hi + 4 * j) = pk8(ov);
        }
    }
    WG_BAR();
}
}
namespace rw {
constexpr int STR = 144, MAT = 64 * STR, FSTR = 68;
constexpr int O_AT = 0, O_BB = MAT, O_RT = 2 * MAT, O_KB = 3 * MAT, O_VT = 4 * MAT, O_BCT = 5 * MAT, O_KCT = 6 * MAT, O_AAK = 7 * MAT, O_ARB = 8 * MAT, O_ARK = 9 * MAT;
constexpr int O_P = 10 * MAT, O_PT = 11 * MAT, O_CS = O_P, O_GC = 12 * MAT, O_P1T = O_BB, O_Q1T = O_KB, PT_OFF = O_GC + 256, LDS_NEED = PT_OFF + 24576;
constexpr int UNIT_BYTES = 32768, UO_G = 0, UO_HT = 8192, UO_Y1 = 16384, UO_Y0 = 24576;
constexpr int NUNITS = 8704, NPROMPT_UNITS = 8192;

struct Args {
    const bf16_t* U; const bf16_t* LW; const bf16_t* AS; const bf16_t* GG; const float* mu; const float* shift_in; const float* state_in;
    const float* k_k; const float* k_a; const float* r_k; const float* lnx_g; const float* lnx_b;
    unsigned char* AOUT; bf16_t* S0; float* RK; bf16_t* OB; float* dout;
};

__device__ __forceinline__ bf16x8 frag_tr(const LAS unsigned char* img, int q, int ks, int lane) {
    const int i16 = lane & 15, g1 = (lane >> 4) & 1, hi = lane >> 5;
    const LAS unsigned char* p = img + (16 * ks + 8 * hi + (i16 >> 2)) * STR + (32 * q + 16 * g1 + 4 * (i16 & 3)) * 2;
    u64x2 v; v.x = vtr64(p); v.y = vtr64(p + 4 * STR); return __builtin_bit_cast(bf16x8, v);
}
template <bool NT = false, bool MT = false>
__device__ __forceinline__ f32x16 mm_tile(const LAS unsigned char* N, const LAS unsigned char* M, int qn, int qm, int r32, int hi, f32x16 acc) {
    const int lane = r32 + 32 * hi;
    const LAS unsigned char* pa = N + (32 * qn + r32) * STR + hi * 16;
    const LAS unsigned char* pb = M + (32 * qm + r32) * STR + hi * 16;
#pragma unroll
    for (int ks = 0; ks < 4; ++ks) {
        const bf16x8 a = NT ? frag_tr(N, qn, ks, lane) : *(const LAS bf16x8*)(pa + ks * 32);
        const bf16x8 b = MT ? frag_tr(M, qm, ks, lane) : *(const LAS bf16x8*)(pb + ks * 32);
        acc = __builtin_amdgcn_mfma_f32_32x32x16_bf16(a, b, acc, 0, 0, 0);
    }
    return acc;
}
__device__ __forceinline__ f32x16 zero16() { f32x16 z;
#pragma unroll
    for (int r = 0; r < 16; ++r) z[r] = 0.f; return z; }
__device__ __forceinline__ void shifted8(const Args& A, int row, int col, bool first, bool sample, int b, float* out) {
    float u[8], p[8];
    unpk8(*(const u32x4*)(A.U + (size_t)row * 3584 + col), u);
    if (!first) unpk8(*(const u32x4*)(A.U + (size_t)(row - 1) * 3584 + col), p);
    else if (sample) { const f32x4 a = *(const f32x4*)(A.shift_in + (size_t)b * 3520 + col), c = *(const f32x4*)(A.shift_in + (size_t)b * 3520 + col + 4); p[0] = a[0]; p[1] = a[1]; p[2] = a[2]; p[3] = a[3]; p[4] = c[0]; p[5] = c[1]; p[6] = c[2]; p[7] = c[3]; }
    else {
#pragma unroll
        for (int e = 0; e < 8; ++e) p[e] = 0.f; }
    const f32x4 m0 = *(const f32x4*)(A.mu + col), m1 = *(const f32x4*)(A.mu + col + 4);
#pragma unroll
    for (int e = 0; e < 8; ++e) { const float mv = e < 4 ? m0[e & 3] : m1[e & 3]; out[e] = u[e] + mv * (p[e] - u[e]); }
}
__device__ __forceinline__ void unit_decode(int u, int& b, int& h, int& row0, bool& sample, bool& firstchunk) {
    if (u < NPROMPT_UNITS) { const int bh = u >> 7, c = u & 127; b = bh >> 4; h = bh & 15; row0 = b * 8192 + c * 64; sample = false; firstchunk = (c == 0); }
    else { const int bh = u - NPROMPT_UNITS; b = bh >> 4; h = bh & 15; row0 = MP + b * 64; sample = true; firstchunk = true; }
}

__device__ __forceinline__ int unit_of(int w) { if (w >= NPROMPT_UNITS) return w; const int h = w & 15, c = (w >> 4) & 127, b = w >> 11; return ((b * 16 + h) << 7) + c; }
struct PrepIn { u32x4 ur, urp, uk, ukp, uv, uvp, asb, lwb; };
__device__ __forceinline__ u32x4 prev_row8(const Args& A, int row, int col) { const int rp = row > 0 ? row - 1 : 0; return *(const u32x4*)(A.U + (size_t)rp * 3584 + col); }
__device__ __forceinline__ u32x4 fix_first8(const Args& A, u32x4 prv, int col, bool first, bool sample, int b) {
    if (first) {
        if (sample) { const f32x4 a = *(const f32x4*)(A.shift_in + (size_t)b * 3520 + col), c = *(const f32x4*)(A.shift_in + (size_t)b * 3520 + col + 4);
            float p[8] = {a[0], a[1], a[2], a[3], c[0], c[1], c[2], c[3]}; prv = pk8(p); }
        else prv = (u32x4){0u, 0u, 0u, 0u};
    }
    return prv;
}
__device__ __forceinline__ void prep_load(const Args& A, int u, PrepIn& in) {
    const int tid = threadIdx.x; int b, h, row0; bool sample, firstchunk; unit_decode(u, b, h, row0, sample, firstchunk);
    const int t = tid >> 3, j0 = 8 * (tid & 7), row = row0 + t, cr = h * 64 + j0;
    const bf16_t* ur = A.U + (size_t)row * 3584 + cr;
    in.ur = *(const u32x4*)ur; in.uk = *(const u32x4*)(ur + 1024); in.uv = *(const u32x4*)(ur + 2048);
    in.urp = prev_row8(A, row, cr); in.ukp = prev_row8(A, row, 1024 + cr); in.uvp = prev_row8(A, row, 2048 + cr);
    in.lwb = *(const u32x4*)(A.LW + (size_t)row * 1024 + cr); in.asb = *(const u32x4*)(A.AS + (size_t)row * 1024 + cr);
}
__device__ __forceinline__ void mix8(const u32x4 cur, const u32x4 prv, const float* mu, float* out) {
    float u[8], p[8]; unpk8(cur, u); unpk8(prv, p);
    const f32x4 m0 = *(const f32x4*)mu, m1 = *(const f32x4*)(mu + 4);
#pragma unroll
    for (int e = 0; e < 8; ++e) { const float mv = e < 4 ? m0[e & 3] : m1[e & 3]; out[e] = u[e] + mv * (p[e] - u[e]); }
}
__device__ __forceinline__ void ld8l(const LAS float* p, float* o) { const f32x4 a = *(const LAS f32x4*)p, c = *(const LAS f32x4*)(p + 4); o[0] = a[0]; o[1] = a[1]; o[2] = a[2]; o[3] = a[3]; o[4] = c[0]; o[5] = c[1]; o[6] = c[2]; o[7] = c[3]; }
__device__ __forceinline__ void mix8l(const u32x4 cur, const u32x4 prv, const LAS float* mu, float* out) {
    float u[8], p[8], m[8]; unpk8(cur, u); unpk8(prv, p); ld8l(mu, m);
#pragma unroll
    for (int e = 0; e < 8; ++e) out[e] = u[e] + m[e] * (p[e] - u[e]);
}
__device__ __forceinline__ void ld8(const float* p, float* o) { const f32x4 a = *(const f32x4*)p, c = *(const f32x4*)(p + 4); o[0] = a[0]; o[1] = a[1]; o[2] = a[2]; o[3] = a[3]; o[4] = c[0]; o[5] = c[1]; o[6] = c[2]; o[7] = c[3]; }

__device__ __forceinline__ void stage_a(LAS unsigned char* lds, const Args& A, int u, PrepIn& in, int u_next) {
    const int tid = threadIdx.x, lane = tid & 63, wid = __builtin_amdgcn_readfirstlane(tid >> 6), r32 = lane & 31, hi = lane >> 5;
    int b, h, row0; bool sample, firstchunk; unit_decode(u, b, h, row0, sample, firstchunk);
    LAS float* CS = (LAS float*)(lds + O_CS); LAS float* GC = (LAS float*)(lds + O_GC);
    {
        const int t = tid >> 3, jg = tid & 7, j0 = 8 * jg, row = row0 + t, cr = h * 64 + j0;
        float r[8], k[8], v[8], lw[8], as[8], L[8];
        float kkp[8], kap[8], rkp[8];
        const LAS float* ptab = (const LAS float*)(lds + PT_OFF) + h * 384 + j0;
        ld8l(ptab, kkp); ld8l(ptab + 64, kap); ld8l(ptab + 128, rkp);
        const bool first = firstchunk && t == 0;
        mix8l(in.ur, fix_first8(A, in.urp, cr, first, sample, b), ptab + 192, r); mix8l(in.uk, fix_first8(A, in.ukp, 1024 + cr, first, sample, b), ptab + 256, k); mix8l(in.uv, fix_first8(A, in.uvp, 2048 + cr, first, sample, b), ptab + 320, v);
        unpk8(in.lwb, lw);
        unpk8(in.asb, as);
#define RW_PIN8(a) asm volatile("" : "+v"(a[0]), "+v"(a[1]), "+v"(a[2]), "+v"(a[3]), "+v"(a[4]), "+v"(a[5]), "+v"(a[6]), "+v"(a[7]))
        RW_PIN8(r); RW_PIN8(k); RW_PIN8(v); RW_PIN8(kkp); RW_PIN8(kap); RW_PIN8(rkp); RW_PIN8(lw); RW_PIN8(as);
#undef RW_PIN8
        asm volatile("" ::: "memory");
        if (u_next >= 0) prep_load(A, u_next, in);
        asm volatile("" ::: "memory");
#pragma unroll
        for (int e = 0; e < 8; ++e) { float x = lw[e];
            float y = __shfl_up(x, 8); if (lane >= 8) x += y; y = __shfl_up(x, 16); if (lane >= 16) x += y; y = __shfl_up(x, 32); if (lane >= 32) x += y; L[e] = x; }
        if (lane >= 56) { *(LAS f32x4*)(CS + wid * 64 + j0) = (f32x4){L[0], L[1], L[2], L[3]}; *(LAS f32x4*)(CS + wid * 64 + j0 + 4) = (f32x4){L[4], L[5], L[6], L[7]}; }
        WG_BAR();
        float LC[8];
#pragma unroll
        for (int e = 0; e < 8; ++e) LC[e] = 0.f;
#pragma unroll
        for (int w = 0; w < 8; ++w) { const f32x4 a = *(const LAS f32x4*)(CS + w * 64 + j0), c = *(const LAS f32x4*)(CS + w * 64 + j0 + 4);
            const float tot[8] = {a[0], a[1], a[2], a[3], c[0], c[1], c[2], c[3]};
#pragma unroll
            for (int e = 0; e < 8; ++e) { LC[e] += tot[e]; if (w < wid) L[e] += tot[e]; } }
        if (t == 63) {
#pragma unroll
            for (int e = 0; e < 8; ++e) GC[j0 + e] = __expf(LC[e]); }
        float kk[8], km[8], bb[8]; float ssq = 0.f, rk = 0.f;
#pragma unroll
        for (int e = 0; e < 8; ++e) { kk[e] = k[e] * kkp[e]; ssq += kk[e] * kk[e]; }
        ssq += __shfl_xor(ssq, 1); ssq += __shfl_xor(ssq, 2); ssq += __shfl_xor(ssq, 4);
        const float inv = rsqrtf(fmaxf(ssq, 1e-24f));
        float oR[8], oA[8], oK[8], oB[8], oBc[8], oKc[8];
#pragma unroll
        for (int e = 0; e < 8; ++e) {
            kk[e] *= inv; km[e] = k[e] * (1.0f + (as[e] - 1.0f) * kap[e]); bb[e] = kk[e] * as[e];
            rk += r[e] * km[e] * rkp[e];
            const float g = __expf(L[e]), gp = __expf(L[e] - lw[e]), gi = __expf(-L[e]), gc = __expf(LC[e] - L[e]);
            oR[e] = r[e] * g; oA[e] = -kk[e] * gp; oK[e] = km[e] * gi; oB[e] = bb[e] * gi;
            oBc[e] = bb[e] * gc; oKc[e] = km[e] * gc;
        }
        rk += __shfl_xor(rk, 1); rk += __shfl_xor(rk, 2); rk += __shfl_xor(rk, 4);
        if (jg == 0) A.RK[(size_t)row * 16 + h] = rk;
        *(LAS u32x4*)(lds + O_RT + t * STR + j0 * 2) = pk8(oR); *(LAS u32x4*)(lds + O_AT + t * STR + j0 * 2) = pk8(oA);
        *(LAS u32x4*)(lds + O_KB + t * STR + j0 * 2) = pk8(oK); *(LAS u32x4*)(lds + O_BB + t * STR + j0 * 2) = pk8(oB);
        *(LAS u32x4*)(lds + O_BCT + t * STR + j0 * 2) = pk8(oBc); *(LAS u32x4*)(lds + O_KCT + t * STR + j0 * 2) = pk8(oKc); *(LAS u32x4*)(lds + O_VT + t * STR + j0 * 2) = pk8(v);
    }
    WG_BAR();
    for (int job = wid; job < 16; job += 8) {
        const int prod = job >> 2, qn = (job >> 1) & 1, qm = job & 1;
        const LAS unsigned char* Nm = lds + (prod == 4 ? O_AT : (prod & 1) ? O_KB : O_BB);
        const LAS unsigned char* Mm = lds + (prod == 4 ? O_BB : (prod & 2) ? O_RT : O_AT);
        const f32x16 acc = mm_tile(Nm, Mm, qn, qm, r32, hi, zero16());
        const int ri = 32 * qm + r32, sgn = (prod == 4) ? -1 : 1, lim = (prod == 2 || prod == 3) ? 1 : 0;
        LAS unsigned char* dst = lds + (prod == 0 ? O_P : prod == 1 ? O_AAK : prod == 2 ? O_ARB : prod == 3 ? O_ARK : O_PT) + ri * STR;
#pragma unroll
        for (int g = 0; g < 4; ++g) {
            const int c0 = 32 * qn + 8 * g + 4 * hi; float o4[4];
#pragma unroll
            for (int e = 0; e < 4; ++e) { const int ci = c0 + e; o4[e] = (sgn * (ci - ri) < lim) ? acc[4 * g + e] : 0.f; }
            u32x2 w; w.x = cvtpk(o4[0], o4[1]); w.y = cvtpk(o4[2], o4[3]); *(LAS u32x2*)(dst + c0 * 2) = w;
        }
    }
    WG_BAR();
    {
        const int qm = wid >> 1, qn = wid & 1;
        LAS unsigned char* ximg = lds + (qm < 2 ? O_P1T + 32 * qm * STR : O_Q1T + 32 * (qm - 2) * STR);
        f32x16 ax;
        if (qm < 2) {
#pragma unroll
            for (int r = 0; r < 16; ++r) ax[r] = bflo((unsigned)*(const LAS unsigned short*)(lds + O_AT + (32 * qn + crow(r, hi)) * STR + (32 * qm + r32) * 2));
        } else ax = mm_tile<false, true>(lds + O_AAK, lds + O_VT, qn, qm - 2, r32, hi, zero16());
#pragma unroll
        for (int g = 0; g < 4; ++g) { u32x2 w; w.x = cvtpk(ax[4 * g], ax[4 * g + 1]); w.y = cvtpk(ax[4 * g + 2], ax[4 * g + 3]); *(LAS u32x2*)(ximg + r32 * STR + (32 * qn + 8 * g + 4 * hi) * 2) = w; }
        WG_BAR();
        const int pq = wid & 3, pqn = pq >> 1, pqm = pq & 1;
        LAS unsigned char* ximg1 = lds + (qm < 2 ? O_AT + 32 * qm * STR : O_AAK + 32 * (qm - 2) * STR);
#pragma unroll 1
        for (int step = 0; step < 6; ++step) {
            const bool rd = step & 1;
            const LAS unsigned char* xr = rd ? ximg1 : ximg; LAS unsigned char* xw = rd ? ximg : ximg1;
            const LAS unsigned char* Pr = lds + (rd ? O_PT : O_P);
            ax = mm_tile(Pr, xr, qn, 0, r32, hi, ax);
            f32x16 ap;
            if (step < 5 && wid < 4) ap = mm_tile<true, false>(Pr, Pr, pqn, pqm, r32, hi, zero16());
#pragma unroll
            for (int g = 0; g < 4; ++g) { u32x2 w; w.x = cvtpk(ax[4 * g], ax[4 * g + 1]); w.y = cvtpk(ax[4 * g + 2], ax[4 * g + 3]); *(LAS u32x2*)(xw + r32 * STR + (32 * qn + 8 * g + 4 * hi) * 2) = w; }
            if (step < 5 && wid < 4) { LAS unsigned char* pd = lds + (rd ? O_P : O_PT) + (32 * pqm + r32) * STR;
#pragma unroll
                for (int g = 0; g < 4; ++g) { u32x2 w; w.x = cvtpk(ap[4 * g], ap[4 * g + 1]); w.y = cvtpk(ap[4 * g + 2], ap[4 * g + 3]); *(LAS u32x2*)(pd + (32 * pqn + 8 * g + 4 * hi) * 2) = w; } }
            WG_BAR();
        }
    }
    {
        unsigned char* uo = A.AOUT + (size_t)u * UNIT_BYTES;
        const int q = wid & 3, qn = q >> 1, qm = q & 1, mrow = 32 * qm + r32;
        if (wid < 4) {
            f32x16 acc = mm_tile<false, true>(lds + O_P1T, lds + O_BCT, qn, qm, r32, hi, zero16());
            const float gcv = GC[mrow];
            bf16_t* Gp = (bf16_t*)(uo + UO_G) + mrow * 64;
#pragma unroll
            for (int g = 0; g < 4; ++g) { const int n0 = 32 * qn + 8 * g + 4 * hi; float o4[4];
#pragma unroll
                for (int e = 0; e < 4; ++e) o4[e] = acc[4 * g + e] + ((n0 + e == mrow) ? gcv : 0.f);
                u32x2 w; w.x = cvtpk(o4[0], o4[1]); w.y = cvtpk(o4[2], o4[3]); *(u32x2*)(Gp + n0) = w; }
            acc = mm_tile<true, false>(lds + O_BCT, lds + O_Q1T, qn, qm, r32, hi, zero16());
            acc = mm_tile<true, true>(lds + O_KCT, lds + O_VT, qn, qm, r32, hi, acc);
            bf16_t* Hp = (bf16_t*)(uo + UO_HT) + mrow * 64;
#pragma unroll
            for (int g = 0; g < 4; ++g) { u32x2 w; w.x = cvtpk(acc[4 * g], acc[4 * g + 1]); w.y = cvtpk(acc[4 * g + 2], acc[4 * g + 3]); *(u32x2*)(Hp + 32 * qn + 8 * g + 4 * hi) = w; }
        } else {
            f32x16 acc = mm_tile(lds + O_P1T, lds + O_ARB, qn, qm, r32, hi, zero16());
            bf16_t* Yp = (bf16_t*)(uo + UO_Y1) + mrow * 64;
#pragma unroll
            for (int g = 0; g < 4; ++g) { const int n0 = 32 * qn + 8 * g + 4 * hi;
                const u32x2 rt = *(const LAS u32x2*)(lds + O_RT + mrow * STR + n0 * 2);
                u32x2 w; w.x = cvtpk(acc[4 * g] + bflo(rt.x), acc[4 * g + 1] + bfhi(rt.x)); w.y = cvtpk(acc[4 * g + 2] + bflo(rt.y), acc[4 * g + 3] + bfhi(rt.y)); *(u32x2*)(Yp + n0) = w; }
            acc = mm_tile(lds + O_Q1T, lds + O_ARB, qn, qm, r32, hi, zero16());
            acc = mm_tile<true, false>(lds + O_VT, lds + O_ARK, qn, qm, r32, hi, acc);
            bf16_t* Y0p = (bf16_t*)(uo + UO_Y0) + mrow * 64;
#pragma unroll
            for (int g = 0; g < 4; ++g) { u32x2 w; w.x = cvtpk(acc[4 * g], acc[4 * g + 1]); w.y = cvtpk(acc[4 * g + 2], acc[4 * g + 3]); *(u32x2*)(Y0p + 32 * qn + 8 * g + 4 * hi) = w; }
        }
    }
}

__device__ __forceinline__ void state_pass_job(const Args& A, int q, int lane) {
    const int r32 = lane & 31, hi = lane >> 5;
    int bh, half, nch, ubase; const float* init; float* fin;
    if (q < 128) { bh = q >> 1; half = q & 1; nch = 128; ubase = bh * 128; init = nullptr; fin = A.dout + OFF_SRP + (size_t)bh * 4096; }
    else { const int qs = q - 128; bh = qs >> 1; half = qs & 1; nch = 1; ubase = NPROMPT_UNITS + bh; init = A.state_in + (size_t)bh * 4096; fin = A.dout + OFF_SRS + (size_t)bh * 4096; }
    const int i = 32 * half + r32;
    f32x16 X[2];
#pragma unroll
    for (int t2 = 0; t2 < 2; ++t2)
#pragma unroll
        for (int g = 0; g < 4; ++g) {
            f32x4 v = (f32x4){0.f, 0.f, 0.f, 0.f};
            if (init) v = *(const f32x4*)(init + i * 64 + 32 * t2 + 8 * g + 4 * hi);
            X[t2][4 * g] = v[0]; X[t2][4 * g + 1] = v[1]; X[t2][4 * g + 2] = v[2]; X[t2][4 * g + 3] = v[3];
        }
    u32x4 gaA[2][2][2], gaB[2][2][2]; u32x4 htA[2][2], htB[2][2];
#define RW_FETCH(ga, ht, c_) do { \
        const unsigned char* uo_ = A.AOUT + (size_t)(ubase + (c_)) * UNIT_BYTES; \
        const bf16_t* Gp_ = (const bf16_t*)(uo_ + UO_G); const bf16_t* Hp_ = (const bf16_t*)(uo_ + UO_HT); \
        _Pragma("unroll") for (int jt = 0; jt < 2; ++jt) { \
            _Pragma("unroll") for (int t2 = 0; t2 < 2; ++t2) \
                _Pragma("unroll") for (int s = 0; s < 2; ++s) ga[jt][t2][s] = *(const u32x4*)(Gp_ + (32 * jt + r32) * 64 + 8 * (4 * t2 + 2 * s + hi)); \
            _Pragma("unroll") for (int g2 = 0; g2 < 2; ++g2) ht[jt][g2] = *(const u32x4*)(Hp_ + i * 64 + 8 * (4 * jt + 2 * g2 + hi)); \
        } } while (0)
#define RW_STEP(ga, ht, c_, NEXT_) do { \
        bf16_t* Sp = A.S0 + (size_t)(ubase + (c_)) * 4096 + i * 64; \
        bf16x8 xb[2][2]; \
        _Pragma("unroll") for (int t2 = 0; t2 < 2; ++t2) { \
            _Pragma("unroll") for (int g2 = 0; g2 < 2; ++g2) { const unsigned a0_ = cvtpk(X[t2][8 * g2], X[t2][8 * g2 + 1]), a1_ = cvtpk(X[t2][8 * g2 + 2], X[t2][8 * g2 + 3]), b0_ = cvtpk(X[t2][8 * g2 + 4], X[t2][8 * g2 + 5]), b1_ = cvtpk(X[t2][8 * g2 + 6], X[t2][8 * g2 + 7]); \
                const auto s0_ = __builtin_amdgcn_permlane32_swap(a0_, b0_, false, false), s1_ = __builtin_amdgcn_permlane32_swap(a1_, b1_, false, false);     \
                *(u32x4*)(Sp + 8 * (4 * t2 + 2 * g2 + hi)) = (u32x4){s0_[0], s1_[0], s0_[1], s1_[1]}; } \
            _Pragma("unroll") for (int s = 0; s < 2; ++s) { u32x4 w; w.x = cvtpk(X[t2][8 * s], X[t2][8 * s + 1]); w.y = cvtpk(X[t2][8 * s + 2], X[t2][8 * s + 3]); w.z = cvtpk(X[t2][8 * s + 4], X[t2][8 * s + 5]); w.w = cvtpk(X[t2][8 * s + 6], X[t2][8 * s + 7]); xb[t2][s] = __builtin_bit_cast(bf16x8, w); } \
        } \
        f32x16 acc[2]; \
        _Pragma("unroll") for (int jt = 0; jt < 2; ++jt) { \
            _Pragma("unroll") for (int g2 = 0; g2 < 2; ++g2) { const u32x4 ck_ = ht[jt][g2]; const auto r0_ = __builtin_amdgcn_permlane32_swap(ck_.x, ck_.z, false, false), r1_ = __builtin_amdgcn_permlane32_swap(ck_.y, ck_.w, false, false); \
                acc[jt][8 * g2] = bflo(r0_[0]); acc[jt][8 * g2 + 1] = bfhi(r0_[0]); acc[jt][8 * g2 + 2] = bflo(r1_[0]); acc[jt][8 * g2 + 3] = bfhi(r1_[0]); \
                acc[jt][8 * g2 + 4] = bflo(r0_[1]); acc[jt][8 * g2 + 5] = bfhi(r0_[1]); acc[jt][8 * g2 + 6] = bflo(r1_[1]); acc[jt][8 * g2 + 7] = bfhi(r1_[1]); } \
            _Pragma("unroll") for (int t2 = 0; t2 < 2; ++t2) \
                _Pragma("unroll") for (int s = 0; s < 2; ++s) { const u32x4 ck_ = ga[jt][t2][s]; const auto r0_ = __builtin_amdgcn_permlane32_swap(ck_.x, ck_.z, false, false), r1_ = __builtin_amdgcn_permlane32_swap(ck_.y, ck_.w, false, false); ga[jt][t2][s] = (u32x4){r0_[0], r1_[0], r0_[1], r1_[1]}; } \
        } \
        _Pragma("unroll") for (int t2 = 0; t2 < 2; ++t2) \
            _Pragma("unroll") for (int s = 0; s < 2; ++s) \
                _Pragma("unroll") for (int jt = 0; jt < 2; ++jt) acc[jt] = __builtin_amdgcn_mfma_f32_32x32x16_bf16(__builtin_bit_cast(bf16x8, ga[jt][t2][s]), xb[t2][s], acc[jt], 0, 0, 0); \
        NEXT_; \
        X[0] = acc[0]; X[1] = acc[1]; } while (0)
    if (q < 128) {
        RW_FETCH(gaA, htA, 0); RW_FETCH(gaB, htB, 1);
#pragma unroll 1
        for (int c = 0; c < 128; c += 2) {
            RW_STEP(gaA, htA, c, RW_FETCH(gaA, htA, min(c + 2, 127)));
            RW_STEP(gaB, htB, c + 1, RW_FETCH(gaB, htB, min(c + 3, 127)));
        }
    } else {
        RW_FETCH(gaA, htA, 0);
        RW_STEP(gaA, htA, 0, (void)0);
    }
#undef RW_FETCH
#undef RW_STEP
#pragma unroll
    for (int t2 = 0; t2 < 2; ++t2)
#pragma unroll
        for (int g = 0; g < 4; ++g) *(f32x4*)(fin + i * 64 + 32 * t2 + 8 * g + 4 * hi) = (f32x4){X[t2][4 * g], X[t2][4 * g + 1], X[t2][4 * g + 2], X[t2][4 * g + 3]};
}

struct ScIn { u32x4 y1a, y1b, s0a, s0b, uva, uvb, upa, upb, gga, ggb; u32x2 y0v[4]; float rk; };
__device__ __forceinline__ void sc_load(const Args& A, int u0, ScIn& in) {
    const int tid = threadIdx.x, lane = tid & 63, wid = __builtin_amdgcn_readfirstlane(tid >> 6), r32 = lane & 31, hi = lane >> 5;
    const int uu = tid >> 8, x = tid & 255, u = unit_of(u0 + uu);
    const unsigned char* uo = A.AOUT + (size_t)u * UNIT_BYTES;
    int b, h, row0; bool sample, firstchunk; unit_decode(u, b, h, row0, sample, firstchunk);
    const int irow = x >> 2, seg = x & 3;
    const bf16_t* y1 = (const bf16_t*)(uo + UO_Y1) + irow * 64 + seg * 16; const bf16_t* s0 = A.S0 + (size_t)u * 4096 + irow * 64 + seg * 16;
    in.y1a = *(const u32x4*)y1; in.y1b = *(const u32x4*)(y1 + 8); in.s0a = *(const u32x4*)s0; in.s0b = *(const u32x4*)(s0 + 8);
    const int q = wid & 3, qn = q >> 1, qm = q & 1, tt = 32 * qm + r32;
    const bf16_t* Y0p = (const bf16_t*)(uo + UO_Y0) + tt * 64;
#pragma unroll
    for (int g = 0; g < 4; ++g) in.y0v[g] = *(const u32x2*)(Y0p + 32 * qn + 8 * g + 4 * hi);
    const int t = x >> 2, ig = x & 3, row = row0 + t, col = h * 64 + 16 * ig;
    in.uva = *(const u32x4*)(A.U + (size_t)row * 3584 + 2048 + col); in.uvb = *(const u32x4*)(A.U + (size_t)row * 3584 + 2048 + col + 8);
    in.upa = prev_row8(A, row, 2048 + col); in.upb = prev_row8(A, row, 2048 + col + 8);
    in.gga = *(const u32x4*)(A.GG + (size_t)row * 1024 + col); in.ggb = *(const u32x4*)(A.GG + (size_t)row * 1024 + col + 8);
    in.rk = A.RK[(size_t)row * 16 + h];
}
__device__ __forceinline__ void stage_c(LAS unsigned char* lds, const Args& A, int u0, const ScIn& in) {
    const int tid = threadIdx.x, lane = tid & 63, wid = __builtin_amdgcn_readfirstlane(tid >> 6), r32 = lane & 31, hi = lane >> 5;
    constexpr int UB = 2 * MAT + 64 * FSTR * 4;
    const int uu = tid >> 8, x = tid & 255, u = unit_of(u0 + uu);
    LAS unsigned char* base = lds + uu * UB;
    int b, h, row0; bool sample, firstchunk; unit_decode(u, b, h, row0, sample, firstchunk);
    const int irow = x >> 2, seg = x & 3;
    const int q = wid & 3, qn = q >> 1, qm = q & 1, tt = 32 * qm + r32;
    const int t = x >> 2, ig = x & 3, i0 = 16 * ig, row = row0 + t, col = h * 64 + i0;
    const bool first = firstchunk && t == 0;
    *(LAS u32x4*)(base + irow * STR + seg * 32) = in.y1a; *(LAS u32x4*)(base + irow * STR + seg * 32 + 16) = in.y1b;
    *(LAS u32x4*)(base + MAT + irow * STR + seg * 32) = in.s0a; *(LAS u32x4*)(base + MAT + irow * STR + seg * 32 + 16) = in.s0b;
    WG_BAR();
    LAS float* Yf = (LAS float*)(base + 2 * MAT);
    {
        f32x16 acc;
#pragma unroll
        for (int g = 0; g < 4; ++g) { acc[4 * g] = bflo(in.y0v[g].x); acc[4 * g + 1] = bfhi(in.y0v[g].x); acc[4 * g + 2] = bflo(in.y0v[g].y); acc[4 * g + 3] = bfhi(in.y0v[g].y); }
        acc = mm_tile(base + MAT, base, qn, qm, r32, hi, acc);
#pragma unroll
        for (int g = 0; g < 4; ++g) *(LAS f32x4*)(Yf + tt * FSTR + 32 * qn + 8 * g + 4 * hi) = (f32x4){acc[4 * g], acc[4 * g + 1], acc[4 * g + 2], acc[4 * g + 3]};
    }
    WG_BAR();
    {
        float y[16]; float s = 0.f;
#pragma unroll
        for (int e4 = 0; e4 < 4; ++e4) { const f32x4 v = *(const LAS f32x4*)(Yf + t * FSTR + i0 + 4 * e4); y[4 * e4] = v[0]; y[4 * e4 + 1] = v[1]; y[4 * e4 + 2] = v[2]; y[4 * e4 + 3] = v[3]; s += (v[0] + v[1]) + (v[2] + v[3]); }
        s += __shfl_xor(s, 1); s += __shfl_xor(s, 2);
        const float mean = s * (1.0f / 64.0f); float q2 = 0.f;
#pragma unroll
        for (int e = 0; e < 16; ++e) { y[e] -= mean; q2 += y[e] * y[e]; }
        q2 += __shfl_xor(q2, 1); q2 += __shfl_xor(q2, 2);
        const float rstd = rsqrtf(q2 * (1.0f / 64.0f) + 64e-5f);
        float v[16], gg[16], lg[16], lb[16], mm_[16];
        ld8(A.lnx_g + col, lg); ld8(A.lnx_g + col + 8, lg + 8); ld8(A.lnx_b + col, lb); ld8(A.lnx_b + col + 8, lb + 8); ld8(A.mu + 2048 + col, mm_); ld8(A.mu + 2048 + col + 8, mm_ + 8);
        { float uu_[16], pp_[16]; unpk8(in.uva, uu_); unpk8(in.uvb, uu_ + 8); unpk8(fix_first8(A, in.upa, 2048 + col, first, sample, b), pp_); unpk8(fix_first8(A, in.upb, 2048 + col + 8, first, sample, b), pp_ + 8);
#pragma unroll
          for (int e = 0; e < 16; ++e) v[e] = uu_[e] + mm_[e] * (pp_[e] - uu_[e]); }
        unpk8(in.gga, gg); unpk8(in.ggb, gg + 8);
        float o[16];
#pragma unroll
        for (int e = 0; e < 16; ++e) o[e] = (y[e] * rstd * lg[e] + lb[e] + in.rk * v[e]) * gg[e];
        *(u32x4*)(A.OB + (size_t)row * 1024 + col) = pk8(o); *(u32x4*)(A.OB + (size_t)row * 1024 + col + 8) = pk8(o + 8);
    }
    WG_BAR();
}
}
constexpr size_t MiB = 1u << 20;
constexpr size_t WS_CTL = 0, CTL_ZERO_BYTES = 1 * MiB;
constexpr int CW_BAR = 4096, CW_QUEUE = 8192;
constexpr size_t CTL_SS1 = 131072, CTL_SS2 = CTL_SS1 + 139264, CTL_SS3 = CTL_SS2 + 139264, CTL_SS4 = CTL_SS3 + 139264;
constexpr size_t WS_W1I = 2 * MiB, WS_W1O = 46 * MiB, WS_WIN = 68 * MiB, WS_WLO = 110 * MiB, WS_WPA = 113 * MiB, WS_WPB = 117 * MiB, WS_WOU = 121 * MiB, WS_W2I = 129 * MiB, WS_W2O = 173 * MiB;
constexpr size_t WS_XB = 196 * MiB;
constexpr size_t WS_OA = WS_XB, WS_OB = WS_XB + 68 * MiB;
constexpr size_t WS_QB = 332 * MiB, WS_KB = 400 * MiB, WS_VB = 464 * MiB;
constexpr size_t WS_MG = 332 * MiB;
constexpr size_t WS_RA = 528 * MiB;
constexpr size_t WS_GA = 936 * MiB, WS_GB = 1072 * MiB;
constexpr size_t WS_U = 1208 * MiB;
constexpr size_t WS_LIN = 828 * MiB;
constexpr size_t WS_LW = 1480 * MiB, WS_AS = 1616 * MiB, WS_GG = 1752 * MiB;
constexpr size_t WS_S0 = 1820 * MiB, WS_RK = 1888 * MiB, WS_XR = 1892 * MiB, WS_END = 2028 * MiB;
constexpr int NWIN = 10752, NLORA = 3072, KLORA = 256, LDLIN = 768;
constexpr int LDS_BYTES = 147456, RING_BYTES = 131072, MISC_OFF = LDS_BYTES - 512;
constexpr int NWAVES = 8;

#define XB_TMO      128
#define XB_XCNT(j)  (256  + 64 * (j))
#define XB_XSUB(j)  (1280 + 64 * (j))
#define XB_XGEN(j)  (2304 + 64 * (j))
#define XB_TOP      3328
#define XB_TOPGEN   3392
#define XCD_BAR_WORDS 3456
#define XB_SPIN_CAP (1u << 18)

__device__ __forceinline__ unsigned xb_ld(unsigned* p)              { return __hip_atomic_load(p, __ATOMIC_RELAXED, __HIP_MEMORY_SCOPE_AGENT); }
__device__ __forceinline__ unsigned xb_add(unsigned* p, unsigned v) { return __hip_atomic_fetch_add(p, v, __ATOMIC_RELAXED, __HIP_MEMORY_SCOPE_AGENT); }
__device__ __forceinline__ unsigned xb_xcc_id() { return (unsigned)__builtin_amdgcn_s_getreg((3 << 11) | 20) & 0xFu; }
#define XB_SPIN(cond, bar) do { unsigned _sp = 0; while (cond) { __builtin_amdgcn_s_sleep(1); \
    if ((++_sp & 255u) == 0u) { if (xb_ld(&(bar)[XB_TMO])) break; if (_sp > XB_SPIN_CAP) { atomicAdd(&(bar)[XB_TMO], 1u); break; } } } } while (0)

struct XcdBarrier {
    unsigned* bar; unsigned x;
    volatile LAS unsigned* st;
};

__device__ __forceinline__ XcdBarrier xcd_barrier_post(unsigned* bar, volatile LAS unsigned* st) {
    XcdBarrier b; b.bar = bar; b.x = xb_xcc_id(); b.st = st;
    if (threadIdx.x == 0) (void)xb_add(&bar[XB_XCNT(b.x)], 1u);
    return b;
}
__device__ __forceinline__ void xcd_barrier_complete(unsigned* bar, unsigned x, unsigned& nloc, unsigned& nx) {
    const unsigned G = gridDim.x * gridDim.y * gridDim.z;
    unsigned sum, cnt, mine, sp = 0u;
    for (;;) {
        sum = 0u; cnt = 0u; mine = 0u;
#pragma unroll
        for (unsigned j = 0; j < 16; ++j) { const unsigned c = xb_ld(&bar[XB_XCNT(j)]); sum += c; cnt += (c > 0u) ? 1u : 0u; mine = (j == x) ? c : mine; }
        if (sum == G) break;
        __builtin_amdgcn_s_sleep(1);
        if ((++sp & 255u) == 0u) { if (xb_ld(&bar[XB_TMO])) break; if (sp > XB_SPIN_CAP) { atomicAdd(&bar[XB_TMO], 1u); break; } }
    }
    nloc = mine > 0u ? mine : 1u; nx = cnt > 0u ? cnt : 1u;
}

__device__ __forceinline__ void xcd_barrier(const XcdBarrier& b) {
    asm volatile("s_waitcnt vmcnt(0)" ::: "memory");
    __syncthreads();
    if (threadIdx.x == 0) {
        unsigned* bar = b.bar;
        __builtin_amdgcn_s_waitcnt(0);
        unsigned nloc = b.st[0], nx = b.st[1];
        if (nloc == 0u) { xcd_barrier_complete(bar, b.x, nloc, nx); b.st[0] = nloc; b.st[1] = nx; }
        const unsigned old = xb_add(&bar[XB_XSUB(b.x)], 1u);
        const unsigned gen = old / nloc;
        if (old + 1u == (gen + 1u) * nloc) {
            __builtin_amdgcn_fence(__ATOMIC_RELEASE, "agent");
            asm volatile("s_waitcnt vmcnt(0)" ::: "memory");
            const unsigned og = xb_add(&bar[XB_TOP], 1u);
            const unsigned tg = og / nx;
            if (og + 1u == (tg + 1u) * nx) xb_add(&bar[XB_TOPGEN], 1u);
            else XB_SPIN(xb_ld(&bar[XB_TOPGEN]) == tg, bar);
            __builtin_amdgcn_fence(__ATOMIC_ACQUIRE, "agent");
            xb_add(&bar[XB_XGEN(b.x)], 1u);
            asm volatile("s_waitcnt vmcnt(0)" ::: "memory");
        } else {
            XB_SPIN(xb_ld(&bar[XB_XGEN(b.x)]) == gen, bar);
            __builtin_amdgcn_fence(__ATOMIC_ACQUIRE, "agent");
            asm volatile("s_waitcnt vmcnt(0)" ::: "memory");
        }
    }
    __syncthreads();
}

struct KArgs { const float* in[34]; float* out; unsigned char* ws; int ph_lo, ph_hi; };
constexpr int NPHASE = 15;

__device__ __forceinline__ float wave_sum(float v) {
#pragma unroll
    for (int o = 1; o < 64; o <<= 1) v += __shfl_xor(v, o);
    return v;
}
template <bool GAIN> __device__ __forceinline__ void transpose_item(const float* W, int K, int N, bf16_t* WT, const float* gain, int k0, int n0, int dst_row0, LAS unsigned char* scr, int lane) {
    asm volatile("" : "+v"(lane));
    const int c4 = lane & 15, kr = lane >> 4;
#pragma unroll
    for (int h8 = 0; h8 < 2; ++h8) {
        f32x4 v[8]; float g[8];
#pragma unroll
        for (int i = 0; i < 8; ++i) { const int k = 4 * (8 * h8 + i) + kr; v[i] = *(const f32x4*)(W + (size_t)(k0 + k) * N + n0 + 4 * c4); if (GAIN) g[i] = gain[k0 + k]; }
#pragma unroll
        for (int i = 0; i < 8; ++i) { const int k = 4 * (8 * h8 + i) + kr; f32x4 x = v[i]; if (GAIN) x = x * g[i]; u32x2 w; w.x = cvtpk(x[0], x[1]); w.y = cvtpk(x[2], x[3]); *(LAS u32x2*)(scr + k * 144 + c4 * 8) = w; }
    }
    asm volatile("s_waitcnt lgkmcnt(0)" ::: "memory");
    const int gq = lane >> 4, i16 = lane & 15;
#pragma unroll
    for (int j = 0; j < 8; ++j) {
        const int kc = 4 * (j & 1) + gq, nb = j >> 1;
        const LAS unsigned char* p = scr + (8 * kc + (i16 >> 2)) * 144 + (16 * nb + 4 * (i16 & 3)) * 2;
        const s16x4 lo = vtr(p), hi = vtr(p + 4 * 144);
        u32x4 o; o.x = (unsigned)(unsigned short)lo[0] | ((unsigned)(unsigned short)lo[1] << 16); o.y = (unsigned)(unsigned short)lo[2] | ((unsigned)(unsigned short)lo[3] << 16);
        o.z = (unsigned)(unsigned short)hi[0] | ((unsigned)(unsigned short)hi[1] << 16); o.w = (unsigned)(unsigned short)hi[2] | ((unsigned)(unsigned short)hi[3] << 16);
        *(u32x4*)(WT + (size_t)(dst_row0 + 16 * nb + i16) * K + k0 + 8 * kc) = o;
    }
    asm volatile("s_waitcnt lgkmcnt(0)" ::: "memory");
}
template <bool GAIN> __device__ __forceinline__ void transpose_matrix(const float* W, int K, int N, bf16_t* WT, const float* gain, int map, LAS unsigned char* scr, int gw, int ngw, int lane) {
    const int nblk = N / 64, nitems = (K / 64) * nblk;
    for (int it = gw; it < nitems; it += ngw) {
        const int kb = it / nblk, nb = it % nblk, n0 = 64 * nb;
        int d0 = n0;
        if (map == 1) d0 = (n0 < FFD) ? 256 * (n0 / 128) + (n0 % 128) : 256 * ((n0 - FFD) / 128) + 128 + ((n0 - FFD) % 128);
        else if (map == 2) d0 = (n0 < 6592) ? n0 : n0 + 64;
        transpose_item<GAIN>(W, K, N, WT, gain, 64 * kb, n0, d0, scr, lane);
    }
}

__global__ void __launch_bounds__(NWAVES * 64, 2) fwd_kernel(KArgs args) {
    extern __shared__ __attribute__((aligned(16))) unsigned char lds_raw[];
    LAS unsigned char* lds = (LAS unsigned char*)lds_raw;
    volatile LAS unsigned* MISC = (volatile LAS unsigned*)(lds + MISC_OFF);
    const int tid = threadIdx.x, lane = tid & 63, wave = __builtin_amdgcn_readfirstlane(tid >> 6);
    const int G = gridDim.x; const int bx = blockIdx.x; const int vcu = (G % 8 == 0) ? (bx % 8) * (G / 8) + bx / 8 : bx;
    unsigned char* ws = args.ws; float* dout = args.out;
    unsigned* ctl = (unsigned*)(ws + WS_CTL);
    for (int u = tid; u < (LDS_BYTES - RING_BYTES) / 4; u += NWAVES * 64) ((LAS unsigned*)(lds + RING_BYTES))[u] = 0u;
    __syncthreads();
    const int lo = args.ph_lo, hi_ = args.ph_hi;
    const bool use_bar = (hi_ - lo) > 1;
    XcdBarrier bar; bar.bar = ctl + CW_BAR; bar.x = 0; bar.st = nullptr;
    if (use_bar) bar = xcd_barrier_post(ctl + CW_BAR, MISC + 8);
#ifndef ONLY_PHASE
#define ONLY_PHASE -1
#endif
#define IN(k) ((ONLY_PHASE < 0 || ONLY_PHASE == (k)) && lo <= (k) && (k) < hi_)
#define SEAM(k) do { if (IN(k) && IN((k) + 1)) xcd_barrier(bar); } while (0)

    const float* x_prompt = args.in[0]; const float* x_sample = args.in[1];
    float* ss1 = (float*)(ws + CTL_SS1); float* ss2 = (float*)(ws + CTL_SS2); float* ss3 = (float*)(ws + CTL_SS3); float* ss4 = (float*)(ws + CTL_SS4);
    bf16_t* W1I = (bf16_t*)(ws + WS_W1I); bf16_t* W1O = (bf16_t*)(ws + WS_W1O); bf16_t* WIN = (bf16_t*)(ws + WS_WIN); bf16_t* WLO = (bf16_t*)(ws + WS_WLO);
    bf16_t* WPA = (bf16_t*)(ws + WS_WPA); bf16_t* WPB = (bf16_t*)(ws + WS_WPB); bf16_t* WOU = (bf16_t*)(ws + WS_WOU); bf16_t* W2I = (bf16_t*)(ws + WS_W2I); bf16_t* W2O = (bf16_t*)(ws + WS_W2O);
    bf16_t* XR = (bf16_t*)(ws + WS_XR); bf16_t* XB = (bf16_t*)(ws + WS_XB); bf16_t* OA = (bf16_t*)(ws + WS_OA); bf16_t* OB = (bf16_t*)(ws + WS_OB);
    bf16_t* QB = (bf16_t*)(ws + WS_QB); bf16_t* KB = (bf16_t*)(ws + WS_KB); bf16_t* VB = (bf16_t*)(ws + WS_VB); bf16_t* MG = (bf16_t*)(ws + WS_MG);
    bf16_t* ACT = (bf16_t*)(ws + WS_RA); bf16_t* GA = (bf16_t*)(ws + WS_GA); bf16_t* GB = (bf16_t*)(ws + WS_GB); bf16_t* U = (bf16_t*)(ws + WS_U); bf16_t* LIN = (bf16_t*)(ws + WS_LIN);
    bf16_t* LW = (bf16_t*)(ws + WS_LW); bf16_t* AS = (bf16_t*)(ws + WS_AS); bf16_t* GG = (bf16_t*)(ws + WS_GG);
    float* X = dout + OFF_YP;

    if (IN(0)) {
        LAS unsigned char* scr = lds + wave * 16384;
        const int gw = vcu * NWAVES + wave, ngw = G * NWAVES;
        transpose_matrix<true>(args.in[7], DM, 2 * FFD, W1I, args.in[6], 1, scr, gw, ngw, lane);
        const int gt = vcu * NWAVES * 64 + tid, ngt = G * NWAVES * 64;
        for (int i = gt; i < 64 * 2048 / 8; i += ngt) *(u32x4*)(WIN + (size_t)6592 * 2048 + (size_t)i * 8) = (u32x4){0u, 0u, 0u, 0u};
        {
            const float* w2 = args.in[18]; const float* a2 = args.in[20]; const float* g2 = args.in[21];
            for (int it = gt; it < NLORA * (KLORA / 8); it += ngt) {
                const int n = it % NLORA, k0 = (it / NLORA) * 8; float o[8];
#pragma unroll
                for (int e = 0; e < 8; ++e) { const int k = k0 + e; float v = 0.f;
                    if (n < 1024) { if (k < 96) v = w2[(size_t)k * 1024 + n]; }
                    else if (n < 2048) { if (k < 96) v = a2[(size_t)k * 1024 + (n - 1024)]; }
                    else v = g2[(size_t)k * 1024 + (n - 2048)];
                    o[e] = v; }
                *(u32x4*)(WLO + (size_t)n * KLORA + k0) = pk8(o);
            }
        }
        for (int m = gw; m < MROWS; m += 2 * ngw) {
            const int m2 = m + ngw; const bool has2 = m2 < MROWS; const int mb = has2 ? m2 : m;
            const float* xa = (m < MP) ? x_prompt + (size_t)m * DM : x_sample + (size_t)(m - MP) * DM;
            const float* xc = (mb < MP) ? x_prompt + (size_t)mb * DM : x_sample + (size_t)(mb - MP) * DM;
            f32x4 va[8], vb[8];
#pragma unroll
            for (int j = 0; j < 8; ++j) { va[j] = *(const f32x4*)(xa + 4 * lane + 256 * j); vb[j] = *(const f32x4*)(xc + 4 * lane + 256 * j); }
            float sa = 0.f, sb = 0.f;
#pragma unroll
            for (int j = 0; j < 8; ++j) { const f32x4 v = va[j]; sa += (v[0] * v[0] + v[1] * v[1]) + (v[2] * v[2] + v[3] * v[3]);
                u32x2 w; w.x = cvtpk(v[0], v[1]); w.y = cvtpk(v[2], v[3]); *(u32x2*)(XB + (size_t)m * DM + 4 * lane + 256 * j) = w; }
            sa = wave_sum(sa);
            if (lane == 0) ss1[m] = sa;
            if (has2) {
#pragma unroll
                for (int j = 0; j < 8; ++j) { const f32x4 v = vb[j]; sb += (v[0] * v[0] + v[1] * v[1]) + (v[2] * v[2] + v[3] * v[3]);
                    u32x2 w; w.x = cvtpk(v[0], v[1]); w.y = cvtpk(v[2], v[3]); *(u32x2*)(XB + (size_t)m2 * DM + 4 * lane + 256 * j) = w; }
                sb = wave_sum(sb);
                if (lane == 0) ss1[m2] = sb;
            }
        }
    }
    SEAM(0);
#define FILLER(nunits_, ...) do { const int nlong_ = (nunits_) % G; if (nlong_ != 0 && bx >= nlong_) { const int fgw = (bx - nlong_) * NWAVES + wave, fngw = (G - nlong_) * NWAVES; LAS unsigned char* fscr = lds + wave * 16384; __VA_ARGS__ __syncthreads(); } } while (0)
    if (IN(1)) FILLER((MROWS / 256) * (2 * FFD / 256), transpose_matrix<false>(args.in[8], FFD, DM, W1O, nullptr, 0, fscr, fgw, fngw, lane););
    if (IN(1)) { pg8::Gemm g{XB, W1I, MROWS, 2 * FFD, DM}; pg8::StaticOrder S; S.init(MROWS, 2 * FFD, G, bx); pg8::EpiSwiGLU E{ACT, ss1};
        pg8::gemm_phase<pg8::EpiSwiGLU, pg8::StaticOrder, true, true>(lds, g, S, E); }
    SEAM(1);
    if (IN(2)) { LAS unsigned char* fscr = lds + wave * 16384; transpose_matrix<true>(args.in[10], DM, 10688, WIN, args.in[9], 2, fscr, vcu * NWAVES + wave, G * NWAVES, lane); __syncthreads(); }
    if (IN(2)) { pg8::Gemm g{ACT, W1O, MROWS, DM, FFD}; pg8::PanelOrder S{bx, 0}; pg8::EpiResid<true, true> E{nullptr, nullptr, XB, nullptr, XR, ss2, 0.5f};
        pg8::gemm_phase<pg8::EpiResid<true, true>, pg8::PanelOrder, true, true>(lds, g, S, E); }
    if (IN(2)) xcd_barrier(bar);
    if (IN(2)) {
        if (bx < 64) { pg8::Gemm g{ACT, W1O, MROWS, DM, FFD}; pg8::PanelOrder S{bx, 1}; pg8::EpiResid<true, true> E{nullptr, nullptr, XB, nullptr, XR, ss2, 0.5f};
            pg8::gemm_phase<pg8::EpiResid<true, true>, pg8::PanelOrder, true, true>(lds, g, S, E); }
        else { pg8::Gemm g{XR, WIN, MROWS, NWIN, DM}; pg8::RangeOrder S{MROWS / 256, NWIN / 256, (MROWS / 256) * (NWIN / 256) / 8, bx & 7, (bx - 64) >> 3, 24, 0, 72}; pg8::EpiWin E{ss2, QB, KB, VB, dout, U, GA, GB};
            pg8::gemm_phase<pg8::EpiWin, pg8::RangeOrder, true, true>(lds, g, S, E); }
    }
    SEAM(2);
    if (IN(3)) { pg8::Gemm g{XR, WIN, MROWS, NWIN, DM}; pg8::RangeOrder S{MROWS / 256, NWIN / 256, (MROWS / 256) * (NWIN / 256) / 8, bx & 7, bx >> 3, 32, 72, 642}; pg8::EpiWin E{ss2, QB, KB, VB, dout, U, GA, GB};
        pg8::gemm_phase<pg8::EpiWin, pg8::RangeOrder, true, true>(lds, g, S, E); }
    if (IN(3)) { if (bx >= 16) { const int fgw = (bx - 16) * NWAVES + wave, fngw = (G - 16) * NWAVES; LAS unsigned char* fscr = lds + wave * 16384;
        transpose_matrix<false>(args.in[27], 1024, DM, WPA, nullptr, 0, fscr, fgw, fngw, lane); transpose_matrix<false>(args.in[28], 1024, DM, WPB, nullptr, 0, fscr, fgw, fngw, lane); transpose_matrix<false>(args.in[29], DM, DM, WOU, nullptr, 0, fscr, fgw, fngw, lane); __syncthreads(); } }
    SEAM(3);
    rw::Args RA;
    RA.U = U; RA.LW = LW; RA.AS = AS; RA.GG = GG; RA.mu = args.in[16]; RA.shift_in = args.in[5]; RA.state_in = args.in[4];
    RA.k_k = args.in[22]; RA.k_a = args.in[23]; RA.r_k = args.in[24]; RA.lnx_g = args.in[25]; RA.lnx_b = args.in[26];
    RA.AOUT = ws + WS_RA; RA.S0 = (bf16_t*)(ws + WS_S0); RA.RK = (float*)(ws + WS_RK); RA.OB = OB; RA.dout = dout;
    if (IN(4)) {
        for (int blk = vcu; blk < MROWS / 16; blk += G) {
            const int row = blk * 16 + (tid >> 5);
            const bool sample = row >= MP; const int t = sample ? ((row - MP) & 63) : (row & 8191), b = sample ? ((row - MP) >> 6) : (row >> 13);
#pragma unroll
            for (int k3 = 0; k3 < 3; ++k3) {
                const int cg = (tid & 31) + 32 * k3;
                float o[8];
                const int src = (cg < 12) ? cg : (cg >= 32 && cg < 44) ? cg - 20 : (cg >= 64) ? cg - 40 : -1;
                if (src >= 0) {
                    rw::shifted8(RA, row, 3072 + 8 * src, t == 0, sample, b, o);
#pragma unroll
                    for (int e = 0; e < 8; ++e) { if (cg < 12) { const float ex = __expf(2.0f * o[e]); o[e] = 1.0f - 2.0f * __builtin_amdgcn_rcpf(ex + 1.0f); } else if (cg >= 64) o[e] = pg8::sigm(o[e]); }
                } else {
#pragma unroll
                    for (int e = 0; e < 8; ++e) o[e] = 0.f; }
                *(u32x4*)(LIN + (size_t)(cg >> 5) * ((size_t)MROWS * 256) + (size_t)row * 256 + 8 * (cg & 31)) = pk8(o);
            }
        }
    }
    SEAM(4);
    if (IN(5)) { pg8::Gemm g{LIN, WLO, MROWS, NLORA, KLORA}; pg8::LoraOrder S; S.so.init(MROWS, NLORA, G, bx); pg8::EpiLora E{args.in[17], args.in[19], LW, AS, GG};
        pg8::gemm_phase<pg8::EpiLora, pg8::LoraOrder, true, true>(lds, g, S, E); }
    SEAM(5);
    if (IN(6)) {
        {
            LAS float* ptab = (LAS float*)(lds + rw::PT_OFF);
            for (int i = tid; i < 16 * 6 * 16; i += NWAVES * 64) { const int hh = i / 96, r = i % 96, arr = r >> 4, j4 = (r & 15) * 4;
                const float* src = (arr == 0 ? RA.k_k : arr == 1 ? RA.k_a : arr == 2 ? RA.r_k : RA.mu + (arr - 3) * 1024) + hh * 64 + j4;
                *(LAS f32x4*)(ptab + hh * 384 + arr * 64 + j4) = *(const f32x4*)src; }
            __syncthreads(); }
        rw::PrepIn pin; if (vcu < rw::NUNITS) rw::prep_load(RA, rw::unit_of(vcu), pin); for (int w = vcu; w < rw::NUNITS; w += G) rw::stage_a(lds, RA, rw::unit_of(w), pin, (w + G < rw::NUNITS) ? rw::unit_of(w + G) : -1); }
    SEAM(6);
    if (IN(7)) {
        float lam;
        { const float a = wave_sum(args.in[11][lane] * args.in[12][lane]), b2 = wave_sum(args.in[13][lane] * args.in[14][lane]); lam = __expf(a) - __expf(b2) + 0.2f; }
        unsigned* qhead = ctl + CW_QUEUE;
        for (;;) {
            if (tid == 0) MISC[16] = __hip_atomic_fetch_add(qhead, 1u, __ATOMIC_RELAXED, __HIP_MEMORY_SCOPE_AGENT);
            __syncthreads();
            const int it = (int)MISC[16];
            __syncthreads();
            if (it >= 2464) break;
            if (it < 32) { if (wave < 4) rw::state_pass_job(RA, it * 4 + wave, lane); }
            else if (it < 160) { rw::state_pass_job(RA, 128 + (it - 32) * 8 + wave, lane); }
            else if (it < 2208) {
                const int j = it - 160, qb = 63 - (j >> 5), bh = j & 31, b = bh >> 3, h = bh & 7;
                att::Src S; S.k = KB + (size_t)b * 8192 * 1024 + h * 128; S.v = VB + (size_t)b * 8192 * 1024 + h * 128; S.kn = nullptr; S.vn = nullptr;
                const size_t r0 = (size_t)b * 8192 + (size_t)qb * 128;
                att::unit<false>(lds, QB + r0 * 1024 + h * 128, S, 2 * qb + 1, 2 * qb + 2, OA + r0 * 1024 + h * 128, lam, args.in[15]);
            } else {
                const int j = it - 2208, b = j >> 3, h = j & 7;
                att::Src S; S.k = args.in[2] + (size_t)b * 4096 * 1024 + h * 128; S.v = args.in[3] + (size_t)b * 4096 * 1024 + h * 128;
                S.kn = dout + OFF_KS + (size_t)b * 64 * 1024 + h * 128; S.vn = dout + OFF_VS + (size_t)b * 64 * 1024 + h * 128;
                att::unit<true>(lds, QB + (size_t)(MP + b * 64) * 1024 + h * 128, S, 65, 0, OA + (size_t)(MP + b * 64) * 1024 + h * 128, lam, args.in[15]);
            }
        }
    }
    SEAM(7);
    if (IN(8)) { rw::ScIn sa, sb; constexpr int NPAIR = rw::NUNITS / 2; if (vcu < NPAIR) rw::sc_load(RA, 2 * vcu, sa);
#pragma unroll 1
        for (int p = vcu; p < NPAIR; p += 2 * G) {
            if (p + G < NPAIR) rw::sc_load(RA, 2 * (p + G), sb);
            rw::stage_c(lds, RA, 2 * p, sa);
            if (p + G < NPAIR) { if (p + 2 * G < NPAIR) rw::sc_load(RA, 2 * (p + 2 * G), sa); rw::stage_c(lds, RA, 2 * (p + G), sb); } } }
    SEAM(8);
    if (IN(10)) FILLER((MROWS / 256) * (DM / 256), transpose_matrix<false>(args.in[32], FFD, DM, W2O, nullptr, 0, fscr, fgw, fngw, lane););
    if (IN(10)) {
        { pg8::Gemm g{OA, WPA, MROWS, DM, 1024}; pg8::StaticOrder S; S.init(MROWS, DM, G, bx); pg8::EpiProj<false> E{GA, MG}; pg8::gemm_phase<pg8::EpiProj<false>, pg8::StaticOrder, true, true>(lds, g, S, E); }
        __syncthreads();
        { pg8::Gemm g{OB, WPB, MROWS, DM, 1024}; pg8::StaticOrder S; S.init(MROWS, DM, G, bx); pg8::EpiProj<true> E{GB, MG}; pg8::gemm_phase<pg8::EpiProj<true>, pg8::StaticOrder, true, true>(lds, g, S, E); }
    }
    SEAM(10);
    if (IN(11)) FILLER((MROWS / 256) * (DM / 256), transpose_matrix<true>(args.in[31], DM, 2 * FFD, W2I, args.in[30], 1, fscr, fgw, fngw, lane););
    if (IN(11)) { pg8::Gemm g{MG, WOU, MROWS, DM, DM}; pg8::StaticOrder S; S.init(MROWS, DM, G, bx); pg8::EpiResid<true, true> E{nullptr, nullptr, XR, nullptr, XB, ss3, 1.0f};
        pg8::gemm_phase<pg8::EpiResid<true, true>, pg8::StaticOrder, true, true>(lds, g, S, E); }
    SEAM(11);
    if (IN(12)) { pg8::Gemm g{XB, W2I, MROWS, 2 * FFD, DM}; pg8::StaticOrder S; S.init(MROWS, 2 * FFD, G, bx); pg8::EpiSwiGLU E{ACT, ss3};
        pg8::gemm_phase<pg8::EpiSwiGLU, pg8::StaticOrder, true, true>(lds, g, S, E); }
    SEAM(12);
    if (IN(13)) { pg8::Gemm g{ACT, W2O, MROWS, DM, FFD}; pg8::PanelOrder S{bx, 0}; pg8::EpiResid<true, true> E{nullptr, nullptr, XB, nullptr, XR, ss4, 0.5f};
        pg8::gemm_phase<pg8::EpiResid<true, true>, pg8::PanelOrder, true, true>(lds, g, S, E); }
    SEAM(13);
#define FINAL_NORM_ROW(m_) do { float* yr = X + (size_t)(m_) * DM; const bf16_t* xr = XR + (size_t)(m_) * DM; const float rs = rsqrtf(ss4[m_] * (1.0f / 2048.0f) + 1e-6f); \
        _Pragma("unroll") for (int j = 0; j < 4; ++j) { const u32x4 w = *(const u32x4*)(xr + 8 * lane + 512 * j); float v[8]; unpk8(w, v); \
            const f32x4 g0 = *(const f32x4*)(fg + 8 * lane + 512 * j), g1 = *(const f32x4*)(fg + 8 * lane + 512 * j + 4); \
            *(f32x4*)(yr + 8 * lane + 512 * j) = (f32x4){v[0] * rs * g0[0], v[1] * rs * g0[1], v[2] * rs * g0[2], v[3] * rs * g0[3]}; \
            *(f32x4*)(yr + 8 * lane + 512 * j + 4) = (f32x4){v[4] * rs * g1[0], v[5] * rs * g1[1], v[6] * rs * g1[2], v[7] * rs * g1[3]}; } } while (0)
    if (IN(14)) {
        const float* fg = args.in[33];
        if (bx < 64) { pg8::Gemm g{ACT, W2O, MROWS, DM, FFD}; pg8::PanelOrder S{bx, 1}; pg8::EpiResid<true, true> E{nullptr, nullptr, XB, nullptr, XR, ss4, 0.5f};
            pg8::gemm_phase<pg8::EpiResid<true, true>, pg8::PanelOrder, true, true>(lds, g, S, E); }
        else { for (int m = (bx - 64) * NWAVES + wave; m < MP; m += (G - 64) * NWAVES) FINAL_NORM_ROW(m); }
        xcd_barrier(bar);
        for (int m = MP + bx * NWAVES + wave; m < MROWS; m += G * NWAVES) FINAL_NORM_ROW(m);
    }
#undef FINAL_NORM_ROW
#undef IN
#undef SEAM
}

extern "C" void kernel_launch(void* const* d_in, const int* in_sizes, int n_in, void* d_out, int out_size, void* d_ws, size_t ws_size, hipStream_t stream) {
    static int grid = 0;
    if (grid == 0) {
        if (n_in != 34 || (size_t)out_size != OUT_TOTAL || ws_size < WS_END) { fprintf(stderr, "kernel_launch: unexpected shapes: n_in %d out %d ws %zu\n", n_in, out_size, ws_size); grid = -1; return; }
        int dev = 0, cus = 0;
        if (hipGetDevice(&dev) != hipSuccess || hipDeviceGetAttribute(&cus, hipDeviceAttributeMultiprocessorCount, dev) != hipSuccess) { grid = -1; return; }
        if (hipFuncSetAttribute((const void*)fwd_kernel, hipFuncAttributeMaxDynamicSharedMemorySize, LDS_BYTES) != hipSuccess) { fprintf(stderr, "kernel_launch: hipFuncSetAttribute failed\n"); grid = -1; return; }
        int per_cu = 0;
        if (hipOccupancyMaxActiveBlocksPerMultiprocessor(&per_cu, (const void*)fwd_kernel, NWAVES * 64, LDS_BYTES) != hipSuccess || per_cu < 1) fprintf(stderr, "kernel_launch: occupancy query says %d\n", per_cu);
        (void)hipGetLastError();
        grid = cus;
    }
    if (grid < 0) return;
    (void)hipMemsetAsync((char*)d_ws + WS_CTL, 0, CTL_ZERO_BYTES, stream);
    KArgs a{};
    for (int i = 0; i < 34; ++i) a.in[i] = (const float*)d_in[i];
    a.out = (float*)d_out; a.ws = (unsigned char*)d_ws;
#ifndef ONE_LAUNCH
#define ONE_LAUNCH 1
#endif
    if (ONE_LAUNCH) { a.ph_lo = 0; a.ph_hi = NPHASE; hipLaunchKernelGGL(fwd_kernel, dim3(grid), dim3(NWAVES * 64), LDS_BYTES, stream, a); }
#ifndef LAST_PHASE
#define LAST_PHASE (NPHASE - 1)
#endif
    else for (int p = 0; p <= LAST_PHASE; ++p) { a.ph_lo = p; a.ph_hi = p + 1; hipLaunchKernelGGL(fwd_kernel, dim3(grid), dim3(NWAVES * 64), LDS_BYTES, stream, a); }
}
```
